# Optimizing an MI355X kernel written in HIP

```python
import jax, jax.numpy as jnp
from jax import lax
import numpy as np

D_MODEL = 1024
BATCH = 2
SEQ = 16384
DEPTH = 4
DEC_BATCH = 16
DEC_SEQ = 32
PAST_LEN = 2048

CHUNK = 64
Q_BLOCK = 128
N_MIXERS = 2
N_FOX = (DEPTH + 1) // 2
N_RET = DEPTH // 2
FOX_HEADS = 16
FOX_HEAD_DIM = D_MODEL // FOX_HEADS
FOX_WIDTH = FOX_HEADS * FOX_HEAD_DIM
FOX_IN_COLS = 4 * FOX_WIDTH + FOX_HEADS
RET_HEADS = 8
RET_QK_DIM = D_MODEL // RET_HEADS
RET_V_DIM = 2 * RET_QK_DIM
RET_QK_WIDTH = RET_HEADS * RET_QK_DIM
RET_V_WIDTH = RET_HEADS * RET_V_DIM
RET_IN_COLS = 2 * RET_QK_WIDTH + 2 * RET_V_WIDTH
D_FF = 2816
RMS_EPS = 1e-6
GN_EPS = 1e-5
ROPE_BASE = 10000.0

kernel_name = 'fox_retention_macaron_stream_step'

F32 = jnp.float32


def _rmsnorm(x, gain):
    xf = x.astype(F32)
    y = xf * lax.rsqrt(jnp.mean(xf * xf, axis=-1, keepdims=True) + RMS_EPS)
    return (y * gain.astype(F32)).astype(x.dtype)


def _swiglu(h, w_in, w_out):
    g, u = jnp.split(h @ w_in, 2, axis=-1)
    return (jax.nn.silu(g) * u) @ w_out


def _fox_project(h, w_in, b_f, q_gain, k_gain):
    b, t, _ = h.shape
    proj = h @ w_in
    W = FOX_WIDTH
    q = proj[..., :W].reshape(b, t, FOX_HEADS, FOX_HEAD_DIM)
    k = proj[..., W:2 * W].reshape(b, t, FOX_HEADS, FOX_HEAD_DIM)
    v = proj[..., 2 * W:3 * W].reshape(b, t, FOX_HEADS, FOX_HEAD_DIM)
    og = proj[..., 3 * W:4 * W]
    fl = proj[..., 4 * W:]
    q = _rmsnorm(q, q_gain)
    k = _rmsnorm(k, k_gain)
    logf = jax.nn.log_sigmoid((fl + b_f).astype(F32))
    return q, k, v, og, logf


def _fox_attend_prompt(q, k, v, logf):
    b, s, h, d = q.shape
    nb = s // Q_BLOCK
    cum = jnp.cumsum(logf, axis=1).swapaxes(1, 2)
    kf = k.astype(F32)
    vf = v.astype(F32)
    qb = q.astype(F32).reshape(b, nb, Q_BLOCK, h, d).swapaxes(0, 1)
    cq = cum.reshape(b, h, nb, Q_BLOCK).transpose(2, 0, 1, 3)
    kpos = jnp.arange(s)
    scale = d ** -0.5

    def block(args):
        qi, ci, i = args
        sc = jnp.einsum('bqhd,bkhd->bhqk', qi, kf) * scale + (ci[..., :, None] - cum[:, :, None, :])
        qpos = i * Q_BLOCK + jnp.arange(Q_BLOCK)
        sc = jnp.where(kpos[None, :] <= qpos[:, None], sc, -jnp.inf)
        p = jax.nn.softmax(sc, axis=-1)
        return jnp.einsum('bhqk,bkhd->bqhd', p, vf)

    o = lax.map(block, (qb, cq, jnp.arange(nb)))
    return o.swapaxes(0, 1).reshape(b, s, h, d).astype(v.dtype)


def _fox_attend_sample(q, k, v, logf, k_cache, v_cache, logf_cache):
    b, n, h, d = q.shape
    past = k_cache.shape[1]
    kall = jnp.concatenate([k_cache.astype(F32), k.astype(F32)], axis=1)
    vall = jnp.concatenate([v_cache.astype(F32), v.astype(F32)], axis=1)
    cum = jnp.cumsum(jnp.concatenate([logf_cache.astype(F32), logf], axis=1), axis=1).swapaxes(1, 2)
    sc = (jnp.einsum('bqhd,bkhd->bhqk', q.astype(F32), kall) * (d ** -0.5)
          + (cum[:, :, past:, None] - cum[:, :, None, :]))
    qpos = past + jnp.arange(n)
    kpos = jnp.arange(past + n)
    sc = jnp.where(kpos[None, :] <= qpos[:, None], sc, -jnp.inf)
    p = jax.nn.softmax(sc, axis=-1)
    return jnp.einsum('bhqk,bkhd->bqhd', p, vall).astype(v.dtype)


def _fox_output(o, og, w_out):
    b, t, _, _ = o.shape
    return (o.reshape(b, t, FOX_WIDTH) * jax.nn.sigmoid(og)) @ w_out


def _ret_log_gamma():
    return jnp.log1p(-jnp.exp2(-5.0 - jnp.arange(RET_HEADS, dtype=F32)))


def _rotary(x, pos):
    half = x.shape[-1] // 2
    inv_freq = ROPE_BASE ** (-jnp.linspace(0.0, 1.0, half, dtype=F32))
    ang = pos[:, None] * inv_freq[None, :]
    cos = jnp.cos(ang)[None, :, None, :]
    sin = jnp.sin(ang)[None, :, None, :]
    x1, x2 = x[..., :half], x[..., half:]
    return jnp.concatenate([x1 * cos - x2 * sin, x1 * sin + x2 * cos], axis=-1)


def _ret_project(h, w_in, pos):
    b, t, _ = h.shape
    proj = h @ w_in
    A, B2 = RET_QK_WIDTH, 2 * RET_QK_WIDTH
    q = proj[..., :A].reshape(b, t, RET_HEADS, RET_QK_DIM).astype(F32)
    k = proj[..., A:B2].reshape(b, t, RET_HEADS, RET_QK_DIM).astype(F32)
    v = proj[..., B2:B2 + RET_V_WIDTH].reshape(b, t, RET_HEADS, RET_V_DIM).astype(F32)
    g = proj[..., B2 + RET_V_WIDTH:]
    q = _rotary(q, pos)
    k = _rotary(k, pos) * (RET_QK_DIM ** -0.5)
    return q, k, v, g


def _ret_chunk(state, q, k, v, lg):
    n = q.shape[1]
    idx = jnp.arange(n, dtype=F32)
    dec_in = jnp.exp(idx[:, None] * lg[None, :])
    dec_out = jnp.exp((n - idx)[:, None] * lg[None, :])
    dmat = jnp.exp(jnp.abs(idx[:, None] - idx[None, :])[None] * lg[:, None, None])
    inter = jnp.einsum('bihd,bhde->bihe', q, state) * dec_in[None, :, :, None]
    sc = jnp.einsum('bihd,bjhd->bhij', q, k) * dmat[None]
    intra = jnp.einsum('bhij,bjhe->bihe', sc, v)
    new_state = (state * jnp.exp(n * lg)[None, :, None, None]
                 + jnp.einsum('bjhd,bjhe->bhde', k * dec_out[None, :, :, None], v))
    return new_state, inter + intra


def _ret_prompt(q, k, v, lg):
    b, s, h, _ = q.shape
    nc = s // CHUNK

    def to_chunks(a):
        return a.reshape(b, nc, CHUNK, *a.shape[2:]).swapaxes(0, 1)

    s0 = jnp.zeros((b, RET_HEADS, RET_QK_DIM, RET_V_DIM), F32)

    def step(st, qkv):
        return _ret_chunk(st, qkv[0], qkv[1], qkv[2], lg)

    s_fin, o = lax.scan(step, s0, (to_chunks(q), to_chunks(k), to_chunks(v)))
    return s_fin, o.swapaxes(0, 1).reshape(b, s, h, RET_V_DIM)


def _ret_output(o, g, w_out):
    b, t, _, _ = o.shape
    mu = jnp.mean(o, axis=-1, keepdims=True)
    var = jnp.mean(jnp.square(o - mu), axis=-1, keepdims=True)
    on = ((o - mu) * lax.rsqrt(var + GN_EPS)).reshape(b, t, RET_V_WIDTH).astype(g.dtype)
    return (jax.nn.silu(g) * on) @ w_out


def setup_inputs(seed: int = 0) -> dict:
    key = jax.random.key(seed)
    ks = jax.random.split(key, 17)

    def nrm(k, shape, scale):
        return jax.random.normal(k, shape, F32) * scale

    return {
        'x_prompt': nrm(ks[0], (BATCH, SEQ, D_MODEL), 1.0),
        'x_sample': nrm(ks[1], (DEC_BATCH, DEC_SEQ, D_MODEL), 1.0),
        'cache_fox_k': nrm(ks[2], (N_FOX, DEC_BATCH, PAST_LEN, FOX_HEADS, FOX_HEAD_DIM), 1.0),
        'cache_fox_v': nrm(ks[3], (N_FOX, DEC_BATCH, PAST_LEN, FOX_HEADS, FOX_HEAD_DIM), 1.0),
        'cache_fox_logf': jax.nn.log_sigmoid(jax.random.uniform(ks[4], (N_FOX, DEC_BATCH, PAST_LEN, FOX_HEADS), F32, 1.0, 4.0)),
        'state_ret': nrm(ks[5], (N_RET, DEC_BATCH, RET_HEADS, RET_QK_DIM, RET_V_DIM), 0.5),
        'norm_gains': 1.0 + nrm(ks[6], (DEPTH, 3, D_MODEL), 0.05),
        'w_ffn_in': nrm(ks[7], (DEPTH, 2, D_MODEL, 2 * D_FF), D_MODEL ** -0.5),
        'w_ffn_out': nrm(ks[8], (DEPTH, 2, D_FF, D_MODEL), D_FF ** -0.5),
        'fox_w_in': nrm(ks[9], (N_FOX, D_MODEL, FOX_IN_COLS), D_MODEL ** -0.5),
        'fox_b_f': jax.random.uniform(ks[10], (N_FOX, FOX_HEADS), F32, 1.0, 4.0),
        'fox_q_gain': 1.0 + nrm(ks[11], (N_FOX, FOX_HEAD_DIM), 0.05),
        'fox_k_gain': 1.0 + nrm(ks[12], (N_FOX, FOX_HEAD_DIM), 0.05),
        'fox_w_out': nrm(ks[13], (N_FOX, FOX_WIDTH, D_MODEL), FOX_WIDTH ** -0.5),
        'ret_w_in': nrm(ks[14], (N_RET, D_MODEL, RET_IN_COLS), D_MODEL ** -0.5),
        'ret_w_out': nrm(ks[15], (N_RET, RET_V_WIDTH, D_MODEL), RET_V_WIDTH ** -0.5),
        'final_gain': 1.0 + nrm(ks[16], (D_MODEL,), 0.05),
    }


def reference(x_prompt, x_sample, cache_fox_k, cache_fox_v, cache_fox_logf, state_ret,
              norm_gains, w_ffn_in, w_ffn_out, fox_w_in, fox_b_f, fox_q_gain, fox_k_gain,
              fox_w_out, ret_w_in, ret_w_out, final_gain):
    seq = x_prompt.shape[1]
    n_new = x_sample.shape[1]
    past = cache_fox_k.shape[2]
    pos_p = jnp.arange(seq, dtype=F32)
    pos_s = past + jnp.arange(n_new, dtype=F32)
    lg = _ret_log_gamma()
    xp, xs = x_prompt, x_sample
    fk_p, fv_p, fl_p, rs_p = [], [], [], []
    fk_s, fv_s, fl_s, rs_s = [], [], [], []
    for layer in range(DEPTH):
        g = norm_gains[layer]
        xp = xp + 0.5 * _swiglu(_rmsnorm(xp, g[0]), w_ffn_in[layer, 0], w_ffn_out[layer, 0])
        xs = xs + 0.5 * _swiglu(_rmsnorm(xs, g[0]), w_ffn_in[layer, 0], w_ffn_out[layer, 0])
        hp = _rmsnorm(xp, g[1])
        hs = _rmsnorm(xs, g[1])
        j = layer // N_MIXERS
        if layer % N_MIXERS == 0:
            q, k, v, og, lf = _fox_project(hp, fox_w_in[j], fox_b_f[j], fox_q_gain[j], fox_k_gain[j])
            xp = xp + _fox_output(_fox_attend_prompt(q, k, v, lf), og, fox_w_out[j])
            fk_p.append(k)
            fv_p.append(v)
            fl_p.append(lf.astype(xp.dtype))
            q, k, v, og, lf = _fox_project(hs, fox_w_in[j], fox_b_f[j], fox_q_gain[j], fox_k_gain[j])
            o = _fox_attend_sample(q, k, v, lf, cache_fox_k[j], cache_fox_v[j], cache_fox_logf[j])
            xs = xs + _fox_output(o, og, fox_w_out[j])
            fk_s.append(k.astype(cache_fox_k.dtype))
            fv_s.append(v.astype(cache_fox_v.dtype))
            fl_s.append(lf.astype(cache_fox_logf.dtype))
        else:
            q, k, v, gt = _ret_project(hp, ret_w_in[j], pos_p)
            st, o = _ret_prompt(q, k, v, lg)
            xp = xp + _ret_output(o, gt, ret_w_out[j])
            rs_p.append(st.astype(xp.dtype))
            q, k, v, gt = _ret_project(hs, ret_w_in[j], pos_s)
            st, o = _ret_chunk(state_ret[j].astype(F32), q, k, v, lg)
            xs = xs + _ret_output(o, gt, ret_w_out[j])
            rs_s.append(st.astype(state_ret.dtype))
        xp = xp + 0.5 * _swiglu(_rmsnorm(xp, g[2]), w_ffn_in[layer, 1], w_ffn_out[layer, 1])
        xs = xs + 0.5 * _swiglu(_rmsnorm(xs, g[2]), w_ffn_in[layer, 1], w_ffn_out[layer, 1])
    y_prompt = _rmsnorm(xp, final_gain)
    y_sample = _rmsnorm(xs, final_gain)
    return (y_prompt, y_sample, jnp.stack(fk_p), jnp.stack(fv_p), jnp.stack(fl_p), jnp.stack(rs_p),
            jnp.stack(fk_s), jnp.stack(fv_s), jnp.stack(fl_s), jnp.stack(rs_s))
```

```cpp
#include <hip/hip_runtime.h>
#include <hip/hip_bf16.h>
#include <cstdio>
#include <cstdint>
#include <cmath>
namespace pg8 {
#define PG8_LAS __attribute__((address_space(3)))
typedef unsigned short bf16_t;
typedef short bf16x8 __attribute__((ext_vector_type(8)));
typedef float f32x4 __attribute__((ext_vector_type(4)));
typedef unsigned u32x4 __attribute__((ext_vector_type(4)));
constexpr int BM = 256, BK = 64, HALF = 128, HTB = HALF * BK * 2  , STAGE_BYTES = 8 * HTB, NXCD = 8, WGM = 8;

__host__ __device__ __forceinline__ int lds_byte(int r, int c) { const int st = (r >> 4) * 2 + (c >> 5), rr = r & 15, cc = c & 31, ob = rr * 64 + cc * 2; return st * 1024 + (ob ^ (((ob >> 9) & 1) << 5)); }
__host__ __device__ __forceinline__ void stage_rc(int b, int& R, int& C) { const int st = b / 1024, sb = b % 1024, swz = sb ^ (((sb >> 9) & 1) << 5); R = (st >> 1) * 16 + swz / 64; C = (st & 1) * 32 + (swz % 64) / 2; }
__host__ __device__ __forceinline__ int perm32(int rho) { const int n = rho >> 4, i = rho & 15; return 8 * (i >> 2) + 4 * n + (i & 3); }

struct Unit { int pm, pn; };
struct Gemm { const bf16_t* A; const bf16_t* Bt; int M, N, K; };

struct StaticOrder {
    int nM, nN, nwg, G, c;
    __host__ __device__ void init(int M, int N, int G_, int c_) { nM = M / BM; nN = N / BM; nwg = nM * nN; G = G_; c = c_; }
    __host__ __device__ bool next(int i, Unit& u) const {
        const long L = (long)i * G + c; if (L >= nwg) return false;
        int wgid = (int)L; { const int q = nwg / NXCD, r = nwg % NXCD, xcd = wgid % NXCD, off = wgid / NXCD; wgid = (xcd < r ? xcd * (q + 1) : r * (q + 1) + (xcd - r) * q) + off; }
        const int nig = WGM * nN, gid = wgid / nig, fm = gid * WGM, gsz = (nM - fm) < WGM ? (nM - fm) : WGM;
        u.pm = fm + ((wgid % nig) % gsz); u.pn = (wgid % nig) / gsz; return true;
    }
    __device__ __forceinline__ void a_ready(const Unit&) const {}
    __device__ __forceinline__ void done(const Unit&) const {}
};

__device__ __forceinline__ unsigned cvt_pk_bf16(float lo, float hi) { unsigned r; asm volatile("v_cvt_pk_bf16_f32 %0, %1, %2" : "=v"(r) : "v"(lo), "v"(hi)); return r; }
typedef float f32x2 __attribute__((ext_vector_type(2)));
constexpr int EP_MP = 32768;
__device__ __forceinline__ unsigned pk_bf16(float lo, float hi) { typedef float f2 __attribute__((ext_vector_type(2))); typedef __bf16 b2 __attribute__((ext_vector_type(2))); f2 v = {lo, hi}; b2 b = __builtin_convertvector(v, b2); return __builtin_bit_cast(unsigned, b); }
__device__ __forceinline__ u32x4 pk8(const f32x4 a, const f32x4 b) { u32x4 w; w.x = pk_bf16(a[0], a[1]); w.y = pk_bf16(a[2], a[3]); w.z = pk_bf16(b[0], b[1]); w.w = pk_bf16(b[2], b[3]); return w; }
__device__ __forceinline__ float sigmoidf_fast(float x) { return __builtin_amdgcn_rcpf(1.0f + __builtin_amdgcn_exp2f(-1.4426950408889634f * x)); }

struct EpiSwiglu {
    static constexpr bool PERM = true, AFTER_DRAIN = false;
    bf16_t* O; int ldc;
    __device__ __forceinline__ void operator()(const f32x4 (&acc)[2][2][4][2], const Unit& u, int wr, int wc, int fr, int fq) const {
        const int row0 = u.pm * BM + wr * 64 + fr, col0 = u.pn * 128 + wc * 32 + 8 * fq;
#pragma unroll
        for (int ai = 0; ai < 2; ++ai)
#pragma unroll
            for (int m = 0; m < 4; ++m) {
                f32x4 h[2];
#pragma unroll
                for (int n = 0; n < 2; ++n) { const f32x4 g = acc[ai][0][m][n], uu = acc[ai][1][m][n];
#pragma unroll
                    for (int e = 0; e < 4; ++e) h[n][e] = g[e] * uu[e] * sigmoidf_fast(g[e]); }
                *(u32x4*)(O + (size_t)(row0 + ai * HALF + m * 16) * ldc + col0) = pk8(h[0], h[1]);
            }
    }
};
struct EpiResid {
    static constexpr bool PERM = true, AFTER_DRAIN = false;
    const float* inP; const float* inS; float* out; float s;
    __device__ __forceinline__ void operator()(const f32x4 (&acc)[2][2][4][2], const Unit& u, int wr, int wc, int fr, int fq) const {
        const int row0 = u.pm * BM + wr * 64 + fr, col0 = u.pn * BM + wc * 32 + 8 * fq;
        const float* in = (u.pm * BM < EP_MP) ? inP : inS;
#pragma unroll
        for (int ai = 0; ai < 2; ++ai)
#pragma unroll
            for (int m = 0; m < 4; ++m) { const size_t off = (size_t)(row0 + ai * HALF + m * 16) * 1024 + col0;
#pragma unroll
                for (int bj = 0; bj < 2; ++bj)
#pragma unroll
                    for (int n = 0; n < 2; ++n) { const f32x4 b = *(const f32x4*)(in + off + bj * HALF + 4 * n); *(f32x4*)(out + off + bj * HALF + 4 * n) = b + acc[ai][bj][m][n] * s; }
                if (m & 1) asm volatile("" ::: "memory"); }
    }
};
struct EpiFoxProj {
    static constexpr bool PERM = true, AFTER_DRAIN = false;
    bf16_t *Q, *K, *V, *OG;
    float *kP, *vP, *kS, *vS;
    const float *qg, *kg;
    float qscale;
    __device__ __forceinline__ void operator()(const f32x4 (&acc)[2][2][4][2], const Unit& u, int wr, int wc, int fr, int fq) const {
        const int seg = u.pn >> 2, head = 4 * (u.pn & 3) + wc;
        const int row0 = u.pm * BM + wr * 64 + fr, colh = head * 64 + 8 * fq;
        f32x4 gn[2][2];
#pragma unroll
        for (int bj = 0; bj < 2; ++bj)
#pragma unroll
            for (int n = 0; n < 2; ++n) gn[bj][n] = (seg <= 1) ? *(const f32x4*)((seg == 0 ? qg : kg) + 32 * bj + 8 * fq + 4 * n) : (f32x4){1.f, 1.f, 1.f, 1.f};
        bf16_t* dstb = (seg == 0) ? Q : (seg == 1) ? K : (seg == 2) ? V : OG;
#pragma unroll
        for (int ai = 0; ai < 2; ++ai)
#pragma unroll
            for (int m = 0; m < 4; ++m) {
                const int row = row0 + ai * HALF + m * 16;
                f32x4 v[2][2];
#pragma unroll
                for (int bj = 0; bj < 2; ++bj)
#pragma unroll
                    for (int n = 0; n < 2; ++n) v[bj][n] = acc[ai][bj][m][n];
                if (seg <= 1) {
                    float ss = 0.f;
#pragma unroll
                    for (int bj = 0; bj < 2; ++bj)
#pragma unroll
                        for (int n = 0; n < 2; ++n) { const f32x4 x = v[bj][n]; ss += (x[0] * x[0] + x[1] * x[1]) + (x[2] * x[2] + x[3] * x[3]); }
                    ss += __int_as_float(__builtin_amdgcn_ds_bpermute((fr + 16 * (fq ^ 1)) << 2, __float_as_int(ss))); ss += __int_as_float(__builtin_amdgcn_ds_bpermute((fr + 16 * (fq ^ 2)) << 2, __float_as_int(ss)));
                    float rinv = 1.0f / sqrtf(ss * (1.0f / 64.0f) + 1e-6f); if (seg == 0) rinv *= qscale;
#pragma unroll
                    for (int bj = 0; bj < 2; ++bj)
#pragma unroll
                        for (int n = 0; n < 2; ++n) v[bj][n] = v[bj][n] * rinv * gn[bj][n];
                } else if (seg == 3) {
#pragma unroll
                    for (int bj = 0; bj < 2; ++bj)
#pragma unroll
                        for (int n = 0; n < 2; ++n)
#pragma unroll
                            for (int e = 0; e < 4; ++e) v[bj][n][e] = sigmoidf_fast(v[bj][n][e]);
                }
                bf16_t* rp = dstb + (size_t)row * 1024 + colh;
#pragma unroll
                for (int bj = 0; bj < 2; ++bj) *(u32x4*)(rp + 32 * bj) = pk8(v[bj][0], v[bj][1]);
                if (seg == 1 || seg == 2) {
                    float* o = (row < EP_MP) ? ((seg == 1 ? kP : vP) + (size_t)row * 1024) : ((seg == 1 ? kS : vS) + (size_t)(row - EP_MP) * 1024);
                    o += colh;
#pragma unroll
                    for (int bj = 0; bj < 2; ++bj)
#pragma unroll
                        for (int n = 0; n < 2; ++n) *(f32x4*)(o + 32 * bj + 4 * n) = v[bj][n];
                }
            }
    }
};
struct EpiRetProj {
    static constexpr bool PERM = true, AFTER_DRAIN = false;
    bf16_t *RQ, *RK, *RV, *RG;
    __device__ __forceinline__ void operator()(const f32x4 (&acc)[2][2][4][2], const Unit& u, int wr, int wc, int fr, int fq) const {
        const int pn = u.pn, row0 = u.pm * BM + wr * 64 + fr;
        if (pn < 8) {
            const int seg = pn >> 2, head = 2 * (pn & 3) + (wc >> 1), j0 = 32 * (wc & 1) + 8 * fq;
            float invf[2][4];
#pragma unroll
            for (int n = 0; n < 2; ++n)
#pragma unroll
                for (int e = 0; e < 4; ++e) invf[n][e] = __builtin_amdgcn_exp2f(-(float)(j0 + 4 * n + e) * (13.287712379549449f / 63.0f));
            const float ksc = (seg == 1) ? 0.08838834764831845f : 1.0f;
            bf16_t* dst = (seg == 0 ? RQ : RK);
#pragma unroll
            for (int ai = 0; ai < 2; ++ai)
#pragma unroll
                for (int m = 0; m < 4; ++m) {
                    const int row = row0 + ai * HALF + m * 16;
                    const float pos = (float)((row < EP_MP) ? (row & 16383) : (2048 + ((row - EP_MP) & 31)));
                    f32x4 o1[2], o2[2];
#pragma unroll
                    for (int n = 0; n < 2; ++n)
#pragma unroll
                        for (int e = 0; e < 4; ++e) {
                            const float ang = pos * invf[n][e];
                            const float nr = __builtin_rintf(ang * 0.15915493667125702f);
                            const float rev = __builtin_fmaf(ang, 0.15915493667125702f, -nr) + ang * 6.4206382432985265e-09f;
                            const float sn = __builtin_amdgcn_sinf(rev), cs = __builtin_amdgcn_cosf(rev);
                            const float x1 = acc[ai][0][m][n][e] * ksc, x2 = acc[ai][1][m][n][e] * ksc;
                            o1[n][e] = x1 * cs - x2 * sn; o2[n][e] = x1 * sn + x2 * cs;
                        }
                    bf16_t* rp = dst + (size_t)row * 1024 + head * 128 + j0;
                    *(u32x4*)(rp) = pk8(o1[0], o1[1]); *(u32x4*)(rp + 64) = pk8(o2[0], o2[1]);
                }
        } else {
            const bool isg = pn >= 16; bf16_t* dst = isg ? RG : RV;
            const int col0 = 256 * ((pn - 8) & 7) + wc * 32 + 8 * fq;
#pragma unroll
            for (int ai = 0; ai < 2; ++ai)
#pragma unroll
                for (int m = 0; m < 4; ++m) {
                    bf16_t* rp = dst + (size_t)(row0 + ai * HALF + m * 16) * 2048 + col0;
#pragma unroll
                    for (int bj = 0; bj < 2; ++bj) { f32x4 a = acc[ai][bj][m][0], b = acc[ai][bj][m][1];
                        if (isg) {
#pragma unroll
                            for (int e = 0; e < 4; ++e) { a[e] = a[e] * sigmoidf_fast(a[e]); b[e] = b[e] * sigmoidf_fast(b[e]); } }
                        *(u32x4*)(rp + bj * HALF) = pk8(a, b); }
                }
        }
    }
};
template <class Epi, class Sched, bool ALIGN_EPI = false, bool SP2 = false, int KC = 0>
__device__ __forceinline__ void gemm_phase(PG8_LAS unsigned char* lds, const Gemm g, const Sched& S, const Epi& E) {
    int tid_ = threadIdx.x; asm volatile("" : "+v"(tid_));
    const int tid = tid_, wid = __builtin_amdgcn_readfirstlane(tid >> 6), lane = tid & 63, wr = wid >> 2, wc = wid & 3, fr = lane & 15, fq = lane >> 4;
    const int K = KC ? KC : g.K, nt = K / BK;
    unsigned voffA[2], voffB[2];
#pragma unroll
    for (int i = 0; i < 2; ++i) { int R, C; stage_rc(tid * 16 + i * 8192, R, C); const int Rb = Epi::PERM ? ((R & ~31) + perm32(R & 31)) : R;
        voffA[i] = (unsigned)(R * K + C) * 2u; voffB[i] = (unsigned)(Rb * K + C) * 2u; }
    const size_t kstep = (size_t)(BK * 2);
    const size_t hstep = (size_t)HALF * K * 2;
    const size_t tstep = 2 * hstep;
    const unsigned ldsw = (unsigned)wid * 1024u;
    const int aoff = lds_byte(wr * 64 + fr, fq * 8), boff = lds_byte(wc * 32 + fr, fq * 8);
#define PG8_SA(b, h) (((b) * 2 + (h)) * HTB)
#define PG8_SB(b, h) ((4 + (b) * 2 + (h)) * HTB)
#define PG8_STAGE(bufoff, gbase, voff) do { _Pragma("unroll") for (int _i = 0; _i < 2; ++_i) \
        __builtin_amdgcn_global_load_lds((const unsigned*)((const char*)(gbase) + (voff)[_i]), (PG8_LAS unsigned*)(lds + (bufoff) + ldsw + _i * 8192), 16, 0, 0); } while (0)
#define PG8_LDA(dst, b, h) do { _Pragma("unroll") for (int m = 0; m < 4; ++m) _Pragma("unroll") for (int k = 0; k < 2; ++k) dst[m][k] = *(const PG8_LAS bf16x8*)(lds + PG8_SA(b, h) + aoff + m * 2048 + k * 1024); } while (0)
#define PG8_LDB(dst, b, h) do { _Pragma("unroll") for (int n = 0; n < 2; ++n) _Pragma("unroll") for (int k = 0; k < 2; ++k) dst[n][k] = *(const PG8_LAS bf16x8*)(lds + PG8_SB(b, h) + boff + n * 2048 + k * 1024); } while (0)
#define PG8_MMA(ai, bj, At, Bt) do { __builtin_amdgcn_s_setprio(1); _Pragma("unroll") for (int m = 0; m < 4; ++m) _Pragma("unroll") for (int n = 0; n < 2; ++n) _Pragma("unroll") for (int k = 0; k < 2; ++k) \
        acc[ai][bj][m][n] = __builtin_amdgcn_mfma_f32_16x16x32_bf16(Bt[n][k], At[m][k], acc[ai][bj][m][n], 0, 0, 0); __builtin_amdgcn_s_setprio(0); } while (0)
#define PG8_WAIT_V(n) asm volatile("s_waitcnt vmcnt(" #n ")" ::: "memory")
#define PG8_WAIT_L(n) asm volatile("s_waitcnt lgkmcnt(" #n ")" ::: "memory")
#define PG8_BAR __builtin_amdgcn_s_barrier()
#define PG8_SCHED __builtin_amdgcn_sched_barrier(0)
    Unit cur, nxt; int ui = 0;
    if (!S.next(0, cur)) return;
    f32x4 acc[2][2][4][2];
#pragma unroll
    for (int a = 0; a < 2; ++a)
#pragma unroll
        for (int b = 0; b < 2; ++b)
#pragma unroll
            for (int m = 0; m < 4; ++m)
#pragma unroll
                for (int n = 0; n < 2; ++n) acc[a][b][m][n] = (f32x4){0.f, 0.f, 0.f, 0.f};
    bf16x8 At[4][2], B0[2][2], B1[2][2];
    const char* cA = (const char*)g.A + (size_t)cur.pm * tstep; const char* cB = (const char*)g.Bt + (size_t)cur.pn * tstep;
    S.a_ready(cur);
    if constexpr (SP2) {
        PG8_STAGE(PG8_SB(0, 0), cB, voffB); PG8_STAGE(PG8_SB(0, 1), cB + hstep, voffB); PG8_STAGE(PG8_SA(0, 0), cA, voffA); PG8_STAGE(PG8_SA(0, 1), cA + hstep, voffA);
        if (wr == 1) PG8_BAR;
        PG8_WAIT_V(2); PG8_BAR;
        PG8_STAGE(PG8_SB(1, 0), cB + kstep, voffB); PG8_STAGE(PG8_SA(1, 0), cA + kstep, voffA); PG8_STAGE(PG8_SB(1, 1), cB + hstep + kstep, voffB);
        PG8_WAIT_V(6); PG8_BAR;
    } else {
        PG8_STAGE(PG8_SB(0, 0), cB, voffB); PG8_STAGE(PG8_SA(0, 0), cA, voffA); PG8_STAGE(PG8_SB(0, 1), cB + hstep, voffB); PG8_STAGE(PG8_SA(0, 1), cA + hstep, voffA);
        if (wr == 1) PG8_BAR;
        PG8_WAIT_V(4); PG8_BAR;
        PG8_STAGE(PG8_SB(1, 0), cB + kstep, voffB); PG8_STAGE(PG8_SA(1, 0), cA + kstep, voffA); PG8_STAGE(PG8_SB(1, 1), cB + hstep + kstep, voffB);
        PG8_WAIT_V(6); PG8_BAR;
    }
    for (;;) {
        const bool has_next = S.next(ui + 1, nxt);
        const char* nA = has_next ? (const char*)g.A + (size_t)nxt.pm * tstep : cA; const char* nB = has_next ? (const char*)g.Bt + (size_t)nxt.pn * tstep : cB;
        for (int t = 0; t < nt; t += 2) {
            const bool last = (t == nt - 2);
            const char* a1 = cA + (size_t)(t + 1) * kstep;
            const char* a2 = last ? nA : cA + (size_t)(t + 2) * kstep; const char* b2 = last ? nB : cB + (size_t)(t + 2) * kstep;
            const char* a3 = a2 + kstep; const char* b3 = b2 + kstep;
            if (last && has_next) S.a_ready(nxt);
            if constexpr (SP2) {
            PG8_LDB(B0, 0, 0); PG8_LDB(B1, 0, 1); PG8_SCHED; PG8_LDA(At, 0, 0); PG8_STAGE(PG8_SA(1, 1), a1 + hstep, voffA);
            PG8_WAIT_V(8); PG8_WAIT_L(0); PG8_BAR; PG8_MMA(0, 0, At, B0); PG8_MMA(0, 1, At, B1); PG8_BAR; PG8_SCHED;
            PG8_LDA(At, 0, 1); PG8_STAGE(PG8_SB(0, 0), b2, voffB); PG8_STAGE(PG8_SB(0, 1), b2 + hstep, voffB); PG8_STAGE(PG8_SA(0, 0), a2, voffA);
            PG8_WAIT_V(8); PG8_WAIT_L(0); PG8_BAR; PG8_MMA(1, 0, At, B0); PG8_MMA(1, 1, At, B1); PG8_BAR; PG8_SCHED;
            PG8_LDB(B0, 1, 0); PG8_LDB(B1, 1, 1); PG8_SCHED; PG8_LDA(At, 1, 0); PG8_STAGE(PG8_SA(0, 1), a2 + hstep, voffA);
            PG8_WAIT_V(8); PG8_WAIT_L(0); PG8_BAR; PG8_MMA(0, 0, At, B0); PG8_MMA(0, 1, At, B1); PG8_BAR; PG8_SCHED;
            PG8_LDA(At, 1, 1); PG8_STAGE(PG8_SB(1, 0), b3, voffB); PG8_STAGE(PG8_SB(1, 1), b3 + hstep, voffB); PG8_STAGE(PG8_SA(1, 0), a3, voffA);
            PG8_WAIT_V(8); PG8_WAIT_L(0); PG8_BAR; PG8_MMA(1, 0, At, B0); PG8_MMA(1, 1, At, B1); PG8_BAR; PG8_SCHED;
            } else {
            PG8_LDB(B0, 0, 0); PG8_SCHED; PG8_LDA(At, 0, 0); PG8_STAGE(PG8_SA(1, 1), a1 + hstep, voffA);
            PG8_WAIT_L(8); PG8_BAR; PG8_WAIT_L(0); PG8_MMA(0, 0, At, B0); PG8_BAR; PG8_SCHED;
            PG8_LDB(B1, 0, 1); PG8_STAGE(PG8_SB(0, 0), b2, voffB);
            PG8_BAR; PG8_WAIT_L(0); PG8_MMA(0, 1, At, B1); PG8_BAR;
            PG8_LDA(At, 0, 1); PG8_STAGE(PG8_SA(0, 0), a2, voffA);
            PG8_BAR; PG8_WAIT_L(0); PG8_MMA(1, 0, At, B0); PG8_BAR; PG8_SCHED;
            PG8_STAGE(PG8_SB(0, 1), b2 + hstep, voffB);
            PG8_WAIT_V(6); PG8_BAR; PG8_MMA(1, 1, At, B1); PG8_BAR;
            PG8_LDB(B0, 1, 0); PG8_SCHED; PG8_LDA(At, 1, 0); PG8_STAGE(PG8_SA(0, 1), a2 + hstep, voffA);
            PG8_WAIT_L(8); PG8_BAR; PG8_WAIT_L(0); PG8_MMA(0, 0, At, B0); PG8_BAR; PG8_SCHED;
            PG8_LDB(B1, 1, 1); PG8_STAGE(PG8_SB(1, 0), b3, voffB);
            PG8_BAR; PG8_WAIT_L(0); PG8_MMA(0, 1, At, B1); PG8_BAR;
            PG8_LDA(At, 1, 1); PG8_STAGE(PG8_SA(1, 0), a3, voffA);
            PG8_BAR; PG8_WAIT_L(0); PG8_MMA(1, 0, At, B0); PG8_BAR; PG8_SCHED;
            PG8_STAGE(PG8_SB(1, 1), b3 + hstep, voffB);
            PG8_WAIT_V(6); PG8_BAR; PG8_MMA(1, 1, At, B1); PG8_BAR;
            }
        }
        if constexpr (ALIGN_EPI) { if (wr == 0) PG8_BAR; }
        if constexpr (!Epi::AFTER_DRAIN) { E(acc, cur, wr, wc, fr, fq); S.done(cur); }
        if (!has_next) break;
#pragma unroll
        for (int a = 0; a < 2; ++a)
#pragma unroll
            for (int b = 0; b < 2; ++b)
#pragma unroll
                for (int m = 0; m < 4; ++m)
#pragma unroll
                    for (int n = 0; n < 2; ++n) acc[a][b][m][n] = (f32x4){0.f, 0.f, 0.f, 0.f};
        cur = nxt; cA = nA; cB = nB; ++ui;
        if constexpr (ALIGN_EPI) { if (wr == 1) PG8_BAR; }
    }
    PG8_WAIT_V(0);
    if constexpr (!ALIGN_EPI) { if (wr == 0) PG8_BAR; }
    PG8_BAR;
    if constexpr (Epi::AFTER_DRAIN) { E.fused(acc, cur, wr, wc, fr, fq, lds, wid, lane); S.done(cur); }
#undef PG8_SA
#undef PG8_SB
#undef PG8_STAGE
#undef PG8_LDA
#undef PG8_LDB
#undef PG8_MMA
#undef PG8_WAIT_V
#undef PG8_WAIT_L
#undef PG8_BAR
#undef PG8_SCHED
}
}
#include <hip/hip_bf16.h>
#include <cmath>
namespace attn_body {
using bf16=__hip_bfloat16;
using bf16x8=__attribute__((ext_vector_type(8)))short;
using s16x4=__attribute__((ext_vector_type(4)))short;
using f32x16=__attribute__((ext_vector_type(16)))float;
using u32x4=__attribute__((ext_vector_type(4)))unsigned;
constexpr int BATCH=2,NHEAD=16,SEQ=16384,D=64,DM=NHEAD*D;
constexpr int NW=8,QBLK=32,QB=QBLK*NW,KVBLK=64,NQB=SEQ/QB;
constexpr int ATTN_PITCH=DM, ATTN_UNIT_ROWS=QB;
__device__ __forceinline__ int crow(int r,int hi){return (r&3)+8*(r>>2)+4*hi;}
#define SBAR() __builtin_amdgcn_sched_barrier(0)
__device__ __forceinline__ void cmask(f32x16&p0,f32x16&p1,int jb,int qrel,int hi){
  const float NEG=-INFINITY; int kb=64*jb+4*hi;
  #pragma unroll
  for(int r=0;r<16;++r){int kv=kb+(r&3)+8*(r>>2); if(kv>qrel)p0[r]=NEG; if(kv+32>qrel)p1[r]=NEG;}
}

constexpr int NSLOT=3, SLOTB=8192;
constexpr int LDS_K=0, LDS_V=NSLOT*SLOTB, LDS_WS=2*NSLOT*SLOTB, LDS_OST=LDS_WS+NW*64*4, LDS_CB=LDS_OST+NW*4096, LDS_BYTES=LDS_CB+NW*768;
constexpr float C2=0.125f*1.4426950408889634f;
__device__ __forceinline__ void glds16(const void*gsrc,unsigned lds_dst){unsigned keep;
  asm volatile("s_mov_b32 %0, m0\n\ts_mov_b32 m0, %2\n\ts_nop 0\n\tglobal_load_lds_dwordx4 %1, off\n\ts_mov_b32 m0, %0":"=&s"(keep):"v"(gsrc),"s"(lds_dst):"memory");}
__device__ __forceinline__ void glds16s(const void*sbase,unsigned voff,unsigned lds_dst){unsigned keep;
  asm volatile("s_nop 4\n\ts_mov_b32 %0, m0\n\ts_mov_b32 m0, %3\n\ts_nop 0\n\tglobal_load_lds_dwordx4 %1, %2\n\ts_mov_b32 m0, %0":"=&s"(keep):"v"(voff),"s"(sbase),"s"(lds_dst):"memory");}
__device__ __forceinline__ void glds4s(const void*sbase,unsigned voff,unsigned lds_dst){unsigned keep;
  asm volatile("s_nop 4\n\ts_mov_b32 %0, m0\n\ts_mov_b32 m0, %3\n\ts_nop 0\n\tglobal_load_lds_dword %1, %2\n\ts_mov_b32 m0, %0":"=&s"(keep):"v"(voff),"s"(sbase),"s"(lds_dst):"memory");}
__device__ __forceinline__ float max3f(float a,float b,float c){float r;asm("v_max3_f32 %0, %1, %2, %3":"=v"(r):"v"(a),"v"(b),"v"(c));return r;}
__device__ __forceinline__ float max2f(float a,float b){float r;asm("v_max_f32_e32 %0, %1, %2":"=v"(r):"v"(a),"v"(b));return r;}
__device__ __forceinline__ float fadd_s(float a,float b){float r;asm("v_add_f32_e32 %0, %1, %2":"=v"(r):"v"(a),"v"(b));return r;}
__device__ __forceinline__ float fsub_s(float a,float b){float r;asm("v_sub_f32_e32 %0, %1, %2":"=v"(r):"v"(a),"v"(b));return r;}
typedef float f32x4_t __attribute__((ext_vector_type(4))); typedef float f32x2_t __attribute__((ext_vector_type(2))); typedef __bf16 bf16x2_t __attribute__((ext_vector_type(2)));
__device__ __forceinline__ unsigned cvtpk_s(float lo,float hi){f32x2_t v={lo,hi};bf16x2_t b=__builtin_convertvector(v,bf16x2_t);return __builtin_bit_cast(unsigned,b);}
#define WAIT_BAR(N) asm volatile("s_waitcnt vmcnt(" #N ") lgkmcnt(0)\n\ts_barrier":::"memory")

__device__ __forceinline__ void qkt(f32x16&p0,f32x16&p1,const char*Kslot,const bf16x8*qr,const f32x16&negm,int r32,int hi){
  const char*kb=Kslot+hi*1024+r32*16;
  #pragma unroll
  for(int d0=0;d0<4;++d0){
    const bf16x8 b0=*reinterpret_cast<const bf16x8*>(kb+d0*2048);
    const bf16x8 b1=*reinterpret_cast<const bf16x8*>(kb+d0*2048+512);
    if(d0==0){p0=__builtin_amdgcn_mfma_f32_32x32x16_bf16(b0,qr[0],negm,0,0,0);p1=__builtin_amdgcn_mfma_f32_32x32x16_bf16(b1,qr[0],negm,0,0,0);}
    else{p0=__builtin_amdgcn_mfma_f32_32x32x16_bf16(b0,qr[d0],p0,0,0,0);p1=__builtin_amdgcn_mfma_f32_32x32x16_bf16(b1,qr[d0],p1,0,0,0);}}
}
typedef __attribute__((address_space(3))) const char* lds_cptr;
typedef short v4i16_t __attribute__((ext_vector_type(4)));
__device__ __forceinline__ void kload8(bf16x8*kf,lds_cptr kp){
  kf[0]=*(const __attribute__((address_space(3))) bf16x8*)(kp);      kf[1]=*(const __attribute__((address_space(3))) bf16x8*)(kp+512);
  kf[2]=*(const __attribute__((address_space(3))) bf16x8*)(kp+2048); kf[3]=*(const __attribute__((address_space(3))) bf16x8*)(kp+2560);
  kf[4]=*(const __attribute__((address_space(3))) bf16x8*)(kp+4096); kf[5]=*(const __attribute__((address_space(3))) bf16x8*)(kp+4608);
  kf[6]=*(const __attribute__((address_space(3))) bf16x8*)(kp+6144); kf[7]=*(const __attribute__((address_space(3))) bf16x8*)(kp+6656);
}
__device__ __forceinline__ void kload2(bf16x8*kf,lds_cptr kp,int j){ kf[2*j]=*(const __attribute__((address_space(3))) bf16x8*)(kp+j*2048); kf[2*j+1]=*(const __attribute__((address_space(3))) bf16x8*)(kp+j*2048+512); }
__device__ __forceinline__ s16x4 vtr(lds_cptr p){ return __builtin_bit_cast(s16x4,__builtin_amdgcn_ds_read_tr16_b64_v4i16((__attribute__((address_space(3))) v4i16_t*)p)); }
__device__ __forceinline__ float rowmax(const f32x16&p0,const f32x16&p1){
  float a=max3f(p0[0],p0[1],p1[0]),b=max3f(p0[2],p0[3],p1[1]);a=max3f(a,p1[2],p1[3]);
  #pragma unroll
  for(int r=4;r<16;r+=4){a=max3f(a,p0[r],p0[r+1]);b=max3f(b,p0[r+2],p0[r+3]);a=max3f(a,p1[r],p1[r+1]);b=max3f(b,p1[r+2],p1[r+3]);}
  const float m=max2f(a,b);
  auto rr=__builtin_amdgcn_permlane32_swap(__float_as_uint(m),__float_as_uint(m),false,false);
  return max2f(__uint_as_float(rr[0]),__uint_as_float(rr[1]));
}
__device__ __forceinline__ void pv(f32x16*o,int vb,bf16x8 pa0,bf16x8 pa1,bf16x8 pa2,bf16x8 pa3){
  #pragma unroll
  for(int d0=0;d0<2;++d0){s16x4 lo[4],hi[4];
    #pragma unroll
    for(int ks=0;ks<4;++ks){
      asm volatile("ds_read_b64_tr_b16 %0,%1 offset:%c2":"=&v"(lo[ks]):"v"(vb),"i"(d0*4096+ks*1024):"memory");
      asm volatile("ds_read_b64_tr_b16 %0,%1 offset:%c2":"=&v"(hi[ks]):"v"(vb),"i"(d0*4096+ks*1024+512):"memory");}
    asm volatile("s_waitcnt lgkmcnt(0)":::"memory");SBAR();
    #define PK(k) (bf16x8){lo[k][0],lo[k][1],lo[k][2],lo[k][3],hi[k][0],hi[k][1],hi[k][2],hi[k][3]}
    o[d0]=__builtin_amdgcn_mfma_f32_32x32x16_bf16(pa0,PK(0),o[d0],0,0,0);
    o[d0]=__builtin_amdgcn_mfma_f32_32x32x16_bf16(pa1,PK(1),o[d0],0,0,0);
    o[d0]=__builtin_amdgcn_mfma_f32_32x32x16_bf16(pa2,PK(2),o[d0],0,0,0);
    o[d0]=__builtin_amdgcn_mfma_f32_32x32x16_bf16(pa3,PK(3),o[d0],0,0,0);
    #undef PK
  }
}

#ifndef ATTN_STORE16
#define ATTN_STORE16(p,v) (*(u32x4*)(p)=(v))
#endif
template<int THRL> __device__ __forceinline__ void attn_unit(int b,int h,int qb,int t0,const bf16*Q,const bf16*__restrict__ K,const bf16*__restrict__ V,const bf16*__restrict__ G,const float*__restrict__ ND,bf16*O,char*shm){
  int tid_=threadIdx.x; asm volatile("":"+v"(tid_)); const int tid=tid_,lane=tid&63,r32=lane&31,hi=lane>>5; const int wid=__builtin_amdgcn_readfirstlane(tid>>6);
  const long rowbase=(long)b*SEQ; const int q0=qb*QB;
  const bf16*Qw=Q+(rowbase+q0+wid*QBLK)*DM+h*D;
  const bf16*Kh=K+(rowbase+(long)t0*KVBLK)*DM+h*D,*Vh=V+(rowbase+(long)t0*KVBLK)*DM+h*D;
  const float*NDh=ND+((long)b*NHEAD+h)*SEQ; const float*Ct0=NDh+(long)t0*KVBLK;
  const unsigned lds0=(unsigned)(uintptr_t)shm;
  float*wsf=(float*)(shm+LDS_WS)+wid*64;
  const unsigned koff=(unsigned)(lane*DM+wid*8)*2u;
  const unsigned voff=(unsigned)((16*(wid&3)+(lane>>2))*DM+(wid>>2)*32+(lane&3)*8)*2u;
  const unsigned kdst=lds0+LDS_K+wid*1024, vdst=lds0+LDS_V+wid*1024;
  #define DMA_K(t,slot) glds16s(Kh+(long)(t)*KVBLK*DM,koff,(unsigned)__builtin_amdgcn_readfirstlane(kdst+(slot)))
  #define DMA_V(t,slot) glds16s(Vh+(long)(t)*KVBLK*DM,voff,(unsigned)__builtin_amdgcn_readfirstlane(vdst+(slot)))
  const unsigned cdst=lds0+LDS_CB+wid*768;
  #define DMA_C(t,slot) glds4s(Ct0+(long)(t)*KVBLK,(unsigned)lane*4u,(unsigned)__builtin_amdgcn_readfirstlane(cdst+((slot)>>5)))
  const lds_cptr cbp0=(lds_cptr)shm+LDS_CB+wid*768+hi*16;
  #define BIAS(P0,P1,slot) do{ const lds_cptr cb_=cbp0+((slot)>>5); _Pragma("unroll") for(int g_=0;g_<4;++g_){ const f32x4_t b0_=*(const __attribute__((address_space(3))) f32x4_t*)(cb_+g_*32), b1_=*(const __attribute__((address_space(3))) f32x4_t*)(cb_+128+g_*32); \
      P0[4*g_]+=b0_[0];P0[4*g_+1]+=b0_[1];P0[4*g_+2]+=b0_[2];P0[4*g_+3]+=b0_[3]; P1[4*g_]+=b1_[0];P1[4*g_+1]+=b1_[1];P1[4*g_+2]+=b1_[2];P1[4*g_+3]+=b1_[3]; } }while(0)
  const int vb0=(int)(lds0+LDS_V)+((lane>>4)&1)*32+(lane&3)*8+(4*hi+((lane&15)>>2))*64;
  const char*Kbase=shm+LDS_K; bf16x8 kf[8];
  const lds_cptr shm3=(lds_cptr)shm; const lds_cptr kp0=shm3+LDS_K+hi*1024+r32*16; const lds_cptr vp0=shm3+LDS_V+((lane>>4)&1)*32+(lane&3)*8+(4*hi+((lane&15)>>2))*64;
  const int NT=(q0+QB)/KVBLK-t0;
  DMA_K(0,0);DMA_C(0,0);DMA_V(0,0);DMA_K(1,SLOTB);
  bf16x8 qr[4];
  #pragma unroll
  for(int d0=0;d0<4;++d0)qr[d0]=*reinterpret_cast<const bf16x8*>(&Qw[(long)r32*DM+d0*16+hi*8]);
  const float ndi=NDh[q0+wid*QBLK+r32];
  float mhat,l_reg=0.f;f32x16 o[2];o[0]=f32x16{};o[1]=f32x16{};f32x16 negm;
  const int qrel=wid*QBLK+r32;
  #define CMASK(P0,P1,t) do{int jb_=(t)-(NT-4); if(jb_>=0)cmask(P0,P1,jb_,qrel,hi);}while(0)
  bool resc=false;
  #define START(P0,P1) do{ const float rm=rowmax(P0,P1); resc=false; \
    { const float dl=max2f(rm,0.f); mhat=fadd_s(mhat,dl); \
      _Pragma("unroll") for(int r=0;r<16;++r){P0[r]=fsub_s(P0[r],dl);P1[r]=fsub_s(P1[r],dl);} \
      _Pragma("unroll") for(int r=0;r<16;++r)negm[r]=-mhat; asm volatile("":"+v"(negm)); } \
    _Pragma("unroll") for(int r=0;r<16;++r)P0[r]=__builtin_amdgcn_exp2f(P0[r]); }while(0)
  #define RESC() do{ if(resc){ asm volatile("s_waitcnt lgkmcnt(0)":::"memory"); \
      _Pragma("unroll") for(int d_=0;d_<2;++d_) _Pragma("unroll") for(int r=0;r<16;++r)o[d_][r]*=wsf[crow(r,hi)]; } }while(0)
  f32x16 pA0,pA1,pB0,pB1;
  int sl_prev=0,sl_cur=0,sl_next=SLOTB;
  #define ROT() do{sl_prev=sl_cur;sl_cur=sl_next;sl_next=(sl_next==(NSLOT-1)*SLOTB)?0:sl_next+SLOTB;}while(0)
  DMA_K(2,2*SLOTB);DMA_C(1,SLOTB);
  WAIT_BAR(3);
  mhat=ndi; _Pragma("unroll") for(int r=0;r<16;++r)negm[r]=-ndi; asm volatile("":"+v"(negm));
  qkt(pA0,pA1,Kbase,qr,negm,r32,hi);asm volatile("s_nop 15\n\ts_nop 7":"+v"(pA0),"+v"(pA1));BIAS(pA0,pA1,0);CMASK(pA0,pA1,0);
  START(pA0,pA1);
  _Pragma("unroll") for(int r=0;r<16;++r)pA1[r]=__builtin_amdgcn_exp2f(pA1[r]);
  WAIT_BAR(0);
  DMA_K(3,0);DMA_V(1,SLOTB);DMA_C(2,2*SLOTB);
  ROT();
  kload8(kf,kp0+sl_cur);
  WAIT_BAR(3);
  s16x4 vlo[8],vhi[8]; u32x4 pw0,pw1,pw2,pw3;
  #define PKW(P,B) cvtpk_s(P[B],P[B+1])
  #define PAF(k) __builtin_bit_cast(bf16x8,pw##k)
  #define VFR(i) (bf16x8){vlo[i][0],vlo[i][1],vlo[i][2],vlo[i][3],vhi[i][0],vhi[i][1],vhi[i][2],vhi[i][3]}
  #define PIN(x) asm volatile("":"+v"(x))
  #define MX3(a,b,c) __builtin_fmaxf(__builtin_fmaxf((a),(b)),(c))
  #define GAPA(MF,A0,A1,A2,A3,W0,W1,PW) do{ MF; sacc+=A0; sacc+=A1; sacc+=A2; sacc+=A3; PIN(sacc); W0; W1; PIN(PW); SBAR(); }while(0)
  #define EX(v) __builtin_amdgcn_exp2f(v)
  #define GAPB(MF,X,B) do{ MF; X[B]=EX(X[B]); X[B+1]=EX(X[B+1]); X[B+2]=EX(X[B+2]); X[B+3]=EX(X[B+3]); PIN(X); SBAR(); }while(0)
  #define VRD(i) do{ vlo[i]=vtr(vp_+(((i)>>2)*4096+((i)&3)*1024)); vhi[i]=vtr(vp_+(((i)>>2)*4096+((i)&3)*1024+512)); }while(0)
  #define KRD(G,j) do{ if(G){ kload2(kf,kp0+sl_next,j); SBAR(); } }while(0)
  #define STEP(C0,C1,P0,P1,t,GK,GV,GL,GC) do{ SBAR(); \
    const lds_cptr vp_=vp0+sl_prev; \
    VRD(0); SBAR(); float sacc=(P0[0]+P0[1]); \
    GAPA(C0=__builtin_amdgcn_mfma_f32_32x32x16_bf16(kf[0],qr[0],negm,0,0,0), P0[2],P0[3],P0[4],P0[5],     pw0[0]=PKW(P0,0), pw0[1]=PKW(P0,2), pw0); \
    VRD(4); SBAR(); GAPA(C1=__builtin_amdgcn_mfma_f32_32x32x16_bf16(kf[1],qr[0],negm,0,0,0), P0[6],P0[7],P0[8],P0[9],     pw0[2]=PKW(P0,4), pw0[3]=PKW(P0,6), pw0); \
    VRD(1); SBAR(); GAPA(C0=__builtin_amdgcn_mfma_f32_32x32x16_bf16(kf[2],qr[1],C0,0,0,0),   P0[10],P0[11],P0[12],P0[13], pw1[0]=PKW(P0,8), pw1[1]=PKW(P0,10), pw1); \
    VRD(5); SBAR(); GAPA(C1=__builtin_amdgcn_mfma_f32_32x32x16_bf16(kf[3],qr[1],C1,0,0,0),   P0[14],P0[15],P1[0],P1[1],   pw1[2]=PKW(P0,12),pw1[3]=PKW(P0,14), pw1); \
    VRD(2); SBAR(); GAPA(C0=__builtin_amdgcn_mfma_f32_32x32x16_bf16(kf[4],qr[2],C0,0,0,0),   P1[2],P1[3],P1[4],P1[5],     pw2[0]=PKW(P1,0), pw2[1]=PKW(P1,2), pw2); \
    VRD(6); SBAR(); GAPA(C1=__builtin_amdgcn_mfma_f32_32x32x16_bf16(kf[5],qr[2],C1,0,0,0),   P1[6],P1[7],P1[8],P1[9],     pw2[2]=PKW(P1,4), pw2[3]=PKW(P1,6), pw2); \
    VRD(3); SBAR(); GAPA(C0=__builtin_amdgcn_mfma_f32_32x32x16_bf16(kf[6],qr[3],C0,0,0,0),   P1[10],P1[11],P1[12],P1[13], pw3[0]=PKW(P1,8), pw3[1]=PKW(P1,10), pw3); \
    VRD(7); SBAR(); GAPA(C1=__builtin_amdgcn_mfma_f32_32x32x16_bf16(kf[7],qr[3],C1,0,0,0),   P1[14],P1[15],0.f,0.f,       pw3[2]=PKW(P1,12),pw3[3]=PKW(P1,14), pw3); \
    l_reg+=sacc; \
    if(GK){DMA_K((t)+3,sl_cur);} if(GV){DMA_V((t)+1,sl_next);} if(GC){DMA_C((t)+2,sl_prev);} \
    BIAS(C0,C1,sl_cur); CMASK(C0,C1,t); \
    { float a=MX3(C0[0],C0[1],C1[0]),b=MX3(C0[2],C0[3],C1[1]); a=MX3(a,C1[2],C1[3]); \
      _Pragma("unroll") for(int r=4;r<16;r+=4){a=MX3(a,C0[r],C0[r+1]);b=MX3(b,C0[r+2],C0[r+3]);a=MX3(a,C1[r],C1[r+1]);b=MX3(b,C1[r+2],C1[r+3]);} \
      float rm=__builtin_fmaxf(a,b); { auto rr=__builtin_amdgcn_permlane32_swap(__float_as_uint(rm),__float_as_uint(rm),false,false); rm=__builtin_fmaxf(__uint_as_float(rr[0]),__uint_as_float(rr[1])); } \
      resc=false; \
      if(__builtin_expect(__any(rm>(float)THRL),0)){ const float dl=__builtin_fmaxf(rm,0.f); mhat+=dl; \
        _Pragma("unroll") for(int r=0;r<16;++r){C0[r]-=dl;C1[r]-=dl;} \
        _Pragma("unroll") for(int r=0;r<16;++r)negm[r]=-mhat; asm volatile("":"+v"(negm)); \
        const float f=__builtin_amdgcn_exp2f(-dl); l_reg*=f; if(hi==0)wsf[r32]=f; resc=true; } } \
    SBAR(); \
    GAPB(o[0]=__builtin_amdgcn_mfma_f32_32x32x16_bf16(PAF(0),VFR(0),o[0],0,0,0), C0,0); \
    GAPB(o[1]=__builtin_amdgcn_mfma_f32_32x32x16_bf16(PAF(0),VFR(4),o[1],0,0,0), C0,4); \
    KRD(GL,0); GAPB(o[0]=__builtin_amdgcn_mfma_f32_32x32x16_bf16(PAF(1),VFR(1),o[0],0,0,0), C0,8); \
    KRD(GL,1); GAPB(o[1]=__builtin_amdgcn_mfma_f32_32x32x16_bf16(PAF(1),VFR(5),o[1],0,0,0), C0,12); \
    KRD(GL,2); GAPB(o[0]=__builtin_amdgcn_mfma_f32_32x32x16_bf16(PAF(2),VFR(2),o[0],0,0,0), C1,0); \
    KRD(GL,3); GAPB(o[1]=__builtin_amdgcn_mfma_f32_32x32x16_bf16(PAF(2),VFR(6),o[1],0,0,0), C1,4); \
    GAPB(o[0]=__builtin_amdgcn_mfma_f32_32x32x16_bf16(PAF(3),VFR(3),o[0],0,0,0), C1,8); \
    GAPB(o[1]=__builtin_amdgcn_mfma_f32_32x32x16_bf16(PAF(3),VFR(7),o[1],0,0,0), C1,12); \
    }while(0)
  int t=1;
  #undef CMASK
  #define CMASK(P0,P1,t) do{}while(0)
  for(;t+5<NT;t+=2){
    STEP(pB0,pB1,pA0,pA1,t,true,true,true,true);     WAIT_BAR(3); RESC(); ROT();
    STEP(pA0,pA1,pB0,pB1,t+1,true,true,true,true);   WAIT_BAR(3); RESC(); ROT();
  }
  #undef CMASK
  #define CMASK(P0,P1,t) do{int jb_=(t)-(NT-4); if(jb_>=0)cmask(P0,P1,jb_,qrel,hi);}while(0)
  #define ENDW(tt) do{ if((tt)+3<NT){WAIT_BAR(3);} else if((tt)+2<NT){WAIT_BAR(2);} else {WAIT_BAR(0);} }while(0)
  for(;t+1<NT;t+=2){
    STEP(pB0,pB1,pA0,pA1,t,(t+3<NT),(t+1<NT),(t+1<NT),(t+2<NT));       ENDW(t);   RESC(); ROT();
    STEP(pA0,pA1,pB0,pB1,t+1,(t+4<NT),(t+2<NT),(t+2<NT),(t+3<NT));     ENDW(t+1); RESC(); ROT();
  }
  STEP(pB0,pB1,pA0,pA1,NT-1,false,false,false,false); RESC();
  { float sacc=pB0[0]+pB0[1]; _Pragma("unroll") for(int r=2;r<16;++r)sacc+=pB0[r]; _Pragma("unroll") for(int r=0;r<16;++r)sacc+=pB1[r]; l_reg+=sacc;
    pw0=(u32x4){PKW(pB0,0),PKW(pB0,2),PKW(pB0,4),PKW(pB0,6)};pw1=(u32x4){PKW(pB0,8),PKW(pB0,10),PKW(pB0,12),PKW(pB0,14)};pw2=(u32x4){PKW(pB1,0),PKW(pB1,2),PKW(pB1,4),PKW(pB1,6)};pw3=(u32x4){PKW(pB1,8),PKW(pB1,10),PKW(pB1,12),PKW(pB1,14)};
    SBAR(); pv(o,vb0+sl_cur,PAF(0),PAF(1),PAF(2),PAF(3)); }
  #undef PKW
  #undef PAF
  #undef VFR
  #undef PIN
  #undef MX3
  #undef GAPA
  #undef GAPB
  #undef EX
  #undef VRD
  #undef KRD
  #undef STEP
  #undef ENDW
  {auto rr=__builtin_amdgcn_permlane32_swap(__float_as_uint(l_reg),__float_as_uint(l_reg),false,false);l_reg=__uint_as_float(rr[0])+__uint_as_float(rr[1]);}
  if(hi==0)wsf[32+r32]=l_reg;asm volatile("s_waitcnt lgkmcnt(0)":::"memory");
  float rli[16];
  #pragma unroll
  for(int r=0;r<16;++r)rli[r]=__builtin_amdgcn_rcpf(wsf[32+crow(r,hi)]);
  bf16*Ow=O+(rowbase+q0+wid*QBLK)*DM+h*D;
  { bf16*stg=(bf16*)(shm+LDS_OST)+wid*2048;
    #pragma unroll
    for(int r=0;r<16;++r){const int orow=crow(r,hi);
      #pragma unroll
      for(int d0=0;d0<2;++d0)stg[orow*64+d0*32+r32]=__float2bfloat16(o[d0][r]*rli[r]);}
    asm volatile("s_waitcnt lgkmcnt(0)":::"memory");
    const bf16*Gw=G+(rowbase+q0+wid*QBLK)*DM+h*D;
    #pragma unroll
    for(int i=0;i<4;++i){const int row=i*8+(lane>>3),ch=lane&7; const u32x4 v=*(const u32x4*)(stg+row*64+ch*8); const u32x4 g=*(const u32x4*)(Gw+(long)row*DM+ch*8); u32x4 w;
      #pragma unroll
      for(int e=0;e<4;++e){ const float a0=__uint_as_float(v[e]<<16)*__uint_as_float(g[e]<<16), a1=__uint_as_float(v[e]&0xffff0000u)*__uint_as_float(g[e]&0xffff0000u); w[e]=cvtpk_s(a0,a1); }
      ATTN_STORE16(Ow+(long)row*DM+ch*8,w);} }
  asm volatile("s_waitcnt lgkmcnt(0)\n\ts_barrier":::"memory");
  #undef DMA_K
  #undef DMA_V
  #undef DMA_C
  #undef BIAS
  #undef CMASK
  #undef START
  #undef RESC
  #undef ROT
}
constexpr int ATTN_LDS_BYTES=LDS_BYTES;
#undef SBAR
#undef WAIT_BAR
}
#define GAS __attribute__((address_space(1)))
#define LAS __attribute__((address_space(3)))
typedef unsigned short bf16;
typedef unsigned v4u __attribute__((ext_vector_type(4)));
typedef float f32x4 __attribute__((ext_vector_type(4)));
typedef short bf16x8 __attribute__((ext_vector_type(8)));
typedef GAS unsigned gu32;
typedef GAS unsigned long long gu64;
#define RLX_AGENT __ATOMIC_RELAXED, __HIP_MEMORY_SCOPE_AGENT
#define LDS_WAIT() asm volatile("s_waitcnt lgkmcnt(0)" ::: "memory")
#define VM_WAIT() asm volatile("s_waitcnt vmcnt(0)" ::: "memory")
__device__ __forceinline__ unsigned long long rt() { return __builtin_amdgcn_s_memrealtime(); }
__device__ __forceinline__ unsigned f2bf(float f) { unsigned u = __builtin_bit_cast(unsigned, f); return (u + 0x7fffu + ((u >> 16) & 1u)) >> 16; }
__device__ __forceinline__ unsigned pk2(float lo, float hi) { return f2bf(lo) | (f2bf(hi) << 16); }
__device__ __forceinline__ float bperm(float v, int srclane) { return __int_as_float(__builtin_amdgcn_ds_bpermute(srclane << 2, __float_as_int(v))); }
typedef unsigned u32x4q __attribute__((ext_vector_type(4)));
typedef short v4i16q __attribute__((ext_vector_type(4)));
__device__ __forceinline__ unsigned pkq(float lo, float hi) { typedef float f2_ __attribute__((ext_vector_type(2))); typedef __bf16 b2_ __attribute__((ext_vector_type(2))); f2_ v = {lo, hi}; b2_ b = __builtin_convertvector(v, b2_); return __builtin_bit_cast(unsigned, b); }
#define XB_TMO      128
#define XB_XCNT(j)  (256  + 64 * (j))
#define XB_XSUB(j)  (1280 + 64 * (j))
#define XB_XGEN(j)  (2304 + 64 * (j))
#define XB_TOP      3328
#define XB_TOPGEN   3392
#define XCD_BAR_WORDS 3456
#define XB_SPIN_CAP (1u << 18)

__device__ __forceinline__ unsigned xb_ld(unsigned* p)              { return __hip_atomic_load(p, __ATOMIC_RELAXED, __HIP_MEMORY_SCOPE_AGENT); }
__device__ __forceinline__ unsigned xb_add(unsigned* p, unsigned v) { return __hip_atomic_fetch_add(p, v, __ATOMIC_RELAXED, __HIP_MEMORY_SCOPE_AGENT); }
__device__ __forceinline__ unsigned xb_xcc_id() { return (unsigned)__builtin_amdgcn_s_getreg((3 << 11) | 20) & 0xFu; }
#define XB_SPIN(cond, bar) do { unsigned _sp = 0; while (cond) { __builtin_amdgcn_s_sleep(1); \
    if ((++_sp & 255u) == 0u) { if (xb_ld(&(bar)[XB_TMO])) break; if (_sp > XB_SPIN_CAP) { atomicAdd(&(bar)[XB_TMO], 1u); break; } } } } while (0)

struct XcdBarrier {
    unsigned* bar; unsigned x;
    volatile LAS unsigned* st;
};

__device__ __forceinline__ XcdBarrier xcd_barrier_post(unsigned* bar, volatile LAS unsigned* st) {
    XcdBarrier b; b.bar = bar; b.x = xb_xcc_id(); b.st = st;
    if (threadIdx.x == 0) (void)xb_add(&bar[XB_XCNT(b.x)], 1u);
    return b;
}
__device__ __forceinline__ void xcd_barrier_complete(unsigned* bar, unsigned x, unsigned& nloc, unsigned& nx) {
    const unsigned G = gridDim.x * gridDim.y * gridDim.z;
    unsigned sum, cnt, mine, sp = 0u;
    for (;;) {
        sum = 0u; cnt = 0u; mine = 0u;
#pragma unroll
        for (unsigned j = 0; j < 16; ++j) { const unsigned c = xb_ld(&bar[XB_XCNT(j)]); sum += c; cnt += (c > 0u) ? 1u : 0u; mine = (j == x) ? c : mine; }
        if (sum == G) break;
        __builtin_amdgcn_s_sleep(1);
        if ((++sp & 255u) == 0u) { if (xb_ld(&bar[XB_TMO])) break; if (sp > XB_SPIN_CAP) { atomicAdd(&bar[XB_TMO], 1u); break; } }
    }
    nloc = mine > 0u ? mine : 1u; nx = cnt > 0u ? cnt : 1u;
}

__device__ __forceinline__ void xcd_barrier(const XcdBarrier& b) {
    asm volatile("s_waitcnt vmcnt(0)" ::: "memory");
    __syncthreads();
    if (threadIdx.x == 0) {
        unsigned* bar = b.bar;
        __builtin_amdgcn_s_waitcnt(0);
        unsigned nloc = b.st[0], nx = b.st[1];
        if (nloc == 0u) { xcd_barrier_complete(bar, b.x, nloc, nx); b.st[0] = nloc; b.st[1] = nx; }
        const unsigned old = xb_add(&bar[XB_XSUB(b.x)], 1u);
        const unsigned gen = old / nloc;
        if (old + 1u == (gen + 1u) * nloc) {
            __builtin_amdgcn_fence(__ATOMIC_RELEASE, "agent");
            asm volatile("s_waitcnt vmcnt(0)" ::: "memory");
            const unsigned og = xb_add(&bar[XB_TOP], 1u);
            const unsigned tg = og / nx;
            if (og + 1u == (tg + 1u) * nx) xb_add(&bar[XB_TOPGEN], 1u);
            else XB_SPIN(xb_ld(&bar[XB_TOPGEN]) == tg, bar);
            __builtin_amdgcn_fence(__ATOMIC_ACQUIRE, "agent");
            xb_add(&bar[XB_XGEN(b.x)], 1u);
            asm volatile("s_waitcnt vmcnt(0)" ::: "memory");
        } else {
            XB_SPIN(xb_ld(&bar[XB_XGEN(b.x)]) == gen, bar);
            __builtin_amdgcn_fence(__ATOMIC_ACQUIRE, "agent");
            asm volatile("s_waitcnt vmcnt(0)" ::: "memory");
        }
    }
    __syncthreads();
}
constexpr int NWAVES = 8;
constexpr int DM = 1024, SEQ = 16384, NBATCH = 2, MP = NBATCH * SEQ, DEC_B = 16, DEC_S = 32, PAST = 2048, MS = DEC_B * DEC_S, M = MP + MS;
constexpr int FF = 2816, FOX_COLS = 4112;
constexpr float RMS_EPS = 1e-6f, GN_EPS = 1e-5f, LOG2E = 1.4426950408889634f;
constexpr size_t MiB = 1u << 20;
constexpr size_t WS_CTL = 0, CTL_ZERO_BYTES = 1 * MiB;
constexpr size_t WS_WF = 1 * MiB;
constexpr size_t WS_WFI = 2 * MiB, WFI_STRIDE = 11 * MiB;
constexpr size_t WS_WFO = 90 * MiB, WFO_STRIDE = 11 * MiB / 2;
constexpr size_t WS_WXI = 134 * MiB, WXI_STRIDE = 8 * MiB;
constexpr size_t WS_WXO = 150 * MiB, WXO_STRIDE = 2 * MiB;
constexpr size_t WS_WRI = 154 * MiB, WRI_STRIDE = 12 * MiB;
constexpr size_t WS_WRO = 178 * MiB, WRO_STRIDE = 4 * MiB;
constexpr size_t WS_X = 186 * MiB;
constexpr size_t WS_XN = 316 * MiB;
constexpr size_t WS_BIG = 381 * MiB;
constexpr size_t WS_ACT = WS_BIG;
constexpr size_t WS_Q = WS_BIG, WS_K = WS_BIG + 65 * MiB, WS_V = WS_BIG + 130 * MiB, WS_OG = WS_BIG + 195 * MiB;
constexpr size_t WS_ND = WS_BIG + 260 * MiB;
constexpr size_t WS_LOGF = WS_BIG + 262 * MiB;
constexpr size_t WS_RQ = WS_BIG, WS_RK = WS_BIG + 65 * MiB, WS_RV = WS_BIG + 130 * MiB, WS_RG = WS_BIG + 260 * MiB, WS_RO = WS_BIG + 390 * MiB;
constexpr size_t WS_U = WS_BIG + 520 * MiB;
constexpr size_t WS_END = WS_BIG + 552 * MiB;
constexpr size_t O_YP = 0, O_YS = O_YP + (size_t)MP * DM, O_FKP = O_YS + (size_t)MS * DM, O_FVP = O_FKP + 2 * (size_t)MP * DM, O_FLP = O_FVP + 2 * (size_t)MP * DM,
                 O_RP = O_FLP + 2 * (size_t)MP * 16, O_FKS = O_RP + 2 * (size_t)NBATCH * 8 * 128 * 256, O_FVS = O_FKS + 2 * (size_t)MS * DM, O_FLS = O_FVS + 2 * (size_t)MS * DM,
                 O_RS = O_FLS + 2 * (size_t)MS * 16, O_END = O_RS + 2 * (size_t)DEC_B * 8 * 128 * 256;
static_assert(O_END == 180895744, "output size");
constexpr int CW_BAR = 4096;
constexpr int RING_OFF = 0, RING_BYTES = 131072;
constexpr int LDSCTL_OFF = RING_BYTES, MISC_OFF = LDSCTL_OFF + 320;
constexpr int LDS_BYTES = 147456;
__device__ __forceinline__ float wave_sum(float v, int lane) {
#pragma unroll
    for (int o = 1; o < 64; o <<= 1) v += bperm(v, lane ^ o);
    return v;
}
__device__ __forceinline__ float wave_max(float v, int lane) {
#pragma unroll
    for (int o = 1; o < 64; o <<= 1) v = fmaxf(v, bperm(v, lane ^ o));
    return v;
}
__device__ __forceinline__ void wt_item(const float* W, int ldw, int K, bf16* WT, int k0, int n0, int srccol0, LAS float* scr, int lane) {
#pragma unroll 8
    for (int i = 0; i < 32; ++i) { const int kk = 2 * i + (lane >> 5); scr[kk * 33 + (lane & 31)] = W[(size_t)(k0 + kk) * ldw + srccol0 + (lane & 31)]; }
    LDS_WAIT(); asm volatile("" ::: "memory");
    const int c = lane & 7;
#pragma unroll
    for (int j = 0; j < 4; ++j) { const int n = (lane >> 3) + 8 * j; const LAS float* s = scr + (8 * c) * 33 + n;
        v4u o; o.x = pk2(s[0 * 33], s[1 * 33]); o.y = pk2(s[2 * 33], s[3 * 33]); o.z = pk2(s[4 * 33], s[5 * 33]); o.w = pk2(s[6 * 33], s[7 * 33]);
        *(GAS v4u*)(WT + (size_t)(n0 + n) * K + k0 + 8 * c) = o; }
    LDS_WAIT(); asm volatile("" ::: "memory");
}
__device__ __forceinline__ int src_ffn_in(int n0) { const int pn = n0 >> 8, sel = (n0 >> 7) & 1, j0 = n0 & 127; return sel * FF + 128 * pn + j0; }
__device__ __forceinline__ int src_fox_in(int n0) { const int pn = n0 >> 8, bj = (n0 >> 7) & 1, wc = (n0 >> 5) & 3; return (pn >> 2) * 1024 + (4 * (pn & 3) + wc) * 64 + 32 * bj; }
__device__ __forceinline__ int src_ret_in(int n0) { const int pn = n0 >> 8; if (pn >= 8) return n0; const int bj = (n0 >> 7) & 1, wc = (n0 >> 5) & 3; return (pn >> 2) * 1024 + (2 * (pn & 3) + (wc >> 1)) * 128 + 64 * bj + 32 * (wc & 1); }

struct Ptrs {
    const float *x_prompt, *x_sample, *cache_k, *cache_v, *cache_lf, *state_ret, *norm_gains, *w_ffn_in, *w_ffn_out, *fox_w_in, *fox_b_f, *fox_qg, *fox_kg, *fox_w_out, *ret_w_in, *ret_w_out, *final_gain;
    float* out; unsigned char* ws;
};

__device__ __forceinline__ void p0_prologue(const Ptrs& P, LAS unsigned char* lds, int gw, int NGW, int wave, int lane) {
    LAS float* scr = (LAS float*)(lds + RING_OFF + wave * 16384);
    constexpr int I_FI = 16 * 176, I_FO = 44 * 32, I_XI = 16 * 128, I_XO = 16 * 32, I_RI = 16 * 192, I_RO = 32 * 32;
    constexpr int T_FI = 8 * I_FI, T_FO = T_FI + 8 * I_FO, T_XI = T_FO + 2 * I_XI, T_XO = T_XI + 2 * I_XO, T_RI = T_XO + 2 * I_RI, T_RO = T_RI + 2 * I_RO;
    for (int it = gw; it < T_RO; it += NGW) {
        if (it < T_FI) { const int w = it / I_FI, r = it % I_FI, kb = r / 176, nb = r % 176;
            wt_item(P.w_ffn_in + (size_t)w * 1024 * 5632, 5632, 1024, (bf16*)(P.ws + WS_WFI + w * WFI_STRIDE), 64 * kb, 32 * nb, src_ffn_in(32 * nb), scr, lane); }
        else if (it < T_FO) { const int q = it - T_FI, w = q / I_FO, r = q % I_FO, kb = r / 32, nb = r % 32;
            wt_item(P.w_ffn_out + (size_t)w * 2816 * 1024, 1024, 2816, (bf16*)(P.ws + WS_WFO + w * WFO_STRIDE), 64 * kb, 32 * nb, 32 * nb, scr, lane); }
        else if (it < T_XI) { const int q = it - T_FO, w = q / I_XI, r = q % I_XI, kb = r / 128, nb = r % 128;
            wt_item(P.fox_w_in + (size_t)w * 1024 * FOX_COLS, FOX_COLS, 1024, (bf16*)(P.ws + WS_WXI + w * WXI_STRIDE), 64 * kb, 32 * nb, src_fox_in(32 * nb), scr, lane); }
        else if (it < T_XO) { const int q = it - T_XI, w = q / I_XO, r = q % I_XO, kb = r / 32, nb = r % 32;
            wt_item(P.fox_w_out + (size_t)w * 1024 * 1024, 1024, 1024, (bf16*)(P.ws + WS_WXO + w * WXO_STRIDE), 64 * kb, 32 * nb, 32 * nb, scr, lane); }
        else if (it < T_RI) { const int q = it - T_XO, w = q / I_RI, r = q % I_RI, kb = r / 192, nb = r % 192;
            wt_item(P.ret_w_in + (size_t)w * 1024 * 6144, 6144, 1024, (bf16*)(P.ws + WS_WRI + w * WRI_STRIDE), 64 * kb, 32 * nb, src_ret_in(32 * nb), scr, lane); }
        else { const int q = it - T_RI, w = q / I_RO, r = q % I_RO, kb = r / 32, nb = r % 32;
            wt_item(P.ret_w_out + (size_t)w * 2048 * 1024, 1024, 2048, (bf16*)(P.ws + WS_WRO + w * WRO_STRIDE), 64 * kb, 32 * nb, 32 * nb, scr, lane); }
    }
    float* WF = (float*)(P.ws + WS_WF);
    for (int i = gw * 64 + lane; i < 2 * 16 * 1024; i += NGW * 64) { const int jl = i >> 14, h = (i >> 10) & 15, k = i & 1023; WF[i] = P.fox_w_in[((size_t)jl * 1024 + k) * FOX_COLS + 4096 + h]; }
}

__device__ __forceinline__ float log_sigmoid(float z) { return fminf(z, 0.f) - log1pf(__expf(-fabsf(z))); }

template <bool FL>
__device__ __forceinline__ void norm_phase(const float* xP, const float* xS, const float* gain, bf16* XN, const float* WFl, const float* bfp, float* LOGF, float* outP, float* outS,
                                           LAS unsigned char* lds, int gw, int NGW, int tid, int lane) {
    LAS float* wl = (LAS float*)(lds + RING_OFF);
    if (FL) {
        for (int i = tid; i < 4096; i += NWAVES * 64) ((LAS f32x4*)wl)[i] = ((const f32x4*)WFl)[i];
        __syncthreads();
    }
    f32x4 g[4];
#pragma unroll
    for (int j = 0; j < 4; ++j) g[j] = ((const f32x4*)gain)[lane + 64 * j];
    for (int m = gw; m < M; m += NGW) {
        const float* xrow = (m < MP ? xP : xS) + (size_t)m * DM;
        const GAS f32x4* xr = (const GAS f32x4*)xrow + lane;
        f32x4 v[4]; float s2 = 0.f;
#pragma unroll
        for (int j = 0; j < 4; ++j) { v[j] = xr[64 * j]; s2 += (v[j].x * v[j].x + v[j].y * v[j].y) + (v[j].z * v[j].z + v[j].w * v[j].w); }
        const float rstd = 1.0f / sqrtf(wave_sum(s2, lane) * (1.f / DM) + RMS_EPS);
#pragma unroll
        for (int j = 0; j < 4; ++j) v[j] = v[j] * rstd * g[j];
        GAS unsigned long long* o8 = (GAS unsigned long long*)(XN + (size_t)m * DM) + lane;
#pragma unroll
        for (int j = 0; j < 4; ++j) o8[64 * j] = (unsigned long long)pk2(v[j].x, v[j].y) | ((unsigned long long)pk2(v[j].z, v[j].w) << 32);
        if (FL) {
            float mine = 0.f;
#pragma unroll 1
            for (int h = 0; h < 16; ++h) { float p = 0.f;
#pragma unroll
                for (int j = 0; j < 4; ++j) { const f32x4 w = ((const LAS f32x4*)(wl + h * 1024))[lane + 64 * j]; p += (v[j].x * w.x + v[j].y * w.y) + (v[j].z * w.z + v[j].w * w.w); }
                p = wave_sum(p, lane); if (lane == h) mine = p; }
            if (lane < 16) { const float lf = log_sigmoid(mine + bfp[lane]); LOGF[(size_t)m * 16 + lane] = lf;
                if (m < MP) outP[(size_t)m * 16 + lane] = lf; else outS[(size_t)(m - MP) * 16 + lane] = lf; }
        }
    }
}
__device__ __forceinline__ void final_norm_phase(const float* X, const float* gain, float* yP, float* yS, int gw, int NGW, int lane) {
    f32x4 g[4];
#pragma unroll
    for (int j = 0; j < 4; ++j) g[j] = ((const f32x4*)gain)[lane + 64 * j];
    for (int m = gw; m < M; m += NGW) {
        const GAS f32x4* xr = (const GAS f32x4*)(X + (size_t)m * DM) + lane;
        f32x4 v[4]; float s2 = 0.f;
#pragma unroll
        for (int j = 0; j < 4; ++j) { v[j] = xr[64 * j]; s2 += (v[j].x * v[j].x + v[j].y * v[j].y) + (v[j].z * v[j].z + v[j].w * v[j].w); }
        const float rstd = 1.0f / sqrtf(wave_sum(s2, lane) * (1.f / DM) + RMS_EPS);
        GAS f32x4* o = (GAS f32x4*)((m < MP ? yP + (size_t)m * DM : yS + (size_t)(m - MP) * DM)) + lane;
#pragma unroll
        for (int j = 0; j < 4; ++j) o[64 * j] = v[j] * rstd * g[j];
    }
}
__device__ __forceinline__ void cumsum_unit(const float* LOGF, float* ND, int bh, LAS unsigned char* lds, int tid, int wave, int lane) {
    const int b = bh >> 4, h = bh & 15; LAS float* wt = (LAS float*)(lds + RING_OFF);
    const float* src = LOGF + ((size_t)b * SEQ + (size_t)tid * 32) * 16 + h;
    float v[32]; float run = 0.f;
#pragma unroll
    for (int i = 0; i < 32; ++i) { run += src[(size_t)i * 16]; v[i] = run; }
    float inc = run;
#pragma unroll
    for (int o = 1; o < 64; o <<= 1) { const float t = bperm(inc, lane - o); if (lane >= o) inc += t; }
    if (lane == 63) wt[wave] = inc;
    __syncthreads();
    float base = inc - run;
    for (int w = 0; w < wave; ++w) base += wt[w];
    float* dst = ND + (size_t)bh * SEQ + (size_t)tid * 32;
#pragma unroll
    for (int i = 0; i < 32; i += 4) { f32x4 o; o.x = -LOG2E * (base + v[i]); o.y = -LOG2E * (base + v[i + 1]); o.z = -LOG2E * (base + v[i + 2]); o.w = -LOG2E * (base + v[i + 3]); *(f32x4*)(dst + i) = o; }
    __syncthreads();
}
namespace smp {
typedef short bf16x8 __attribute__((ext_vector_type(8)));
typedef float f32x16 __attribute__((ext_vector_type(16)));
constexpr int L_ND = 0;
constexpr int L_WT = 8448;
constexpr int L_LP = 8704;
constexpr int L_OP = 16384;
constexpr int L_END = L_OP + 65536;
__device__ __forceinline__ int crow(int r, int hi) { return (r & 3) + 8 * (r >> 2) + 4 * hi; }
__device__ __forceinline__ bf16x8 cvt8(const f32x4 a, const f32x4 b) { const u32x4q w = {pkq(a[0], a[1]), pkq(a[2], a[3]), pkq(b[0], b[1]), pkq(b[2], b[3])}; return __builtin_bit_cast(bf16x8, w); }

__device__ __forceinline__ void unit(int jl, int b, int h, const float* kcache, const float* vcache, const float* lfcache, const float* LOGF,
                                     const bf16* Q, const bf16* Kb, const bf16* Vb, const bf16* OG, bf16* OUT, LAS unsigned char* lds) {
    int tid_ = threadIdx.x; asm volatile("" : "+v"(tid_)); const int tid = tid_, lane = tid & 63, wid = __builtin_amdgcn_readfirstlane(tid >> 6);
    const int r32 = lane & 31, hi = lane >> 5;
    LAS float* nd = (LAS float*)(lds + L_ND); LAS float* wt = (LAS float*)(lds + L_WT); LAS float* lp = (LAS float*)(lds + L_LP); LAS float* op = (LAS float*)(lds + L_OP);
    const size_t cb = ((size_t)jl * DEC_B + b) * PAST;
    {
        float v[5]; float run = 0.f;
#pragma unroll
        for (int i = 0; i < 5; ++i) { const int j = tid * 5 + i; float lf = 0.f;
            if (j < PAST) lf = lfcache[(cb + j) * 16 + h]; else if (j < PAST + DEC_S) lf = LOGF[(size_t)(MP + b * DEC_S + (j - PAST)) * 16 + h];
            run += lf; v[i] = run; }
        float inc = run;
#pragma unroll
        for (int o = 1; o < 64; o <<= 1) { const float t = bperm(inc, lane - o); if (lane >= o) inc += t; }
        if (lane == 63) wt[wid] = inc;
        __syncthreads();
        float base = inc - run;
        for (int w = 0; w < wid; ++w) base += wt[w];
#pragma unroll
        for (int i = 0; i < 5; ++i) { const int j = tid * 5 + i; if (j < PAST + DEC_S) nd[j] = -LOG2E * (base + v[i]); }
        __syncthreads();
    }
    const size_t qrow = (size_t)(MP + b * DEC_S + r32) * DM + h * 64;
    bf16x8 qf[4];
#pragma unroll
    for (int s = 0; s < 4; ++s) qf[s] = *(const bf16x8*)(Q + qrow + 16 * s + 8 * hi);
    const float ndi = nd[PAST + r32];
    f32x16 o0 = {}, o1 = {}; float lsum = 0.f;
    for (int T = wid; T < 65; T += NWAVES) {
        f32x16 S;
#pragma unroll
        for (int r = 0; r < 16; ++r) S[r] = -ndi;
        bf16x8 ka[4];
        if (T < 64) { const float* kp = kcache + ((cb + (size_t)T * 32 + r32) * 16 + h) * 64 + 8 * hi;
#pragma unroll
            for (int s = 0; s < 4; ++s) ka[s] = cvt8(*(const f32x4*)(kp + 16 * s), *(const f32x4*)(kp + 16 * s + 4)); }
        else { const bf16* kp = Kb + (size_t)(MP + b * DEC_S + r32) * DM + h * 64 + 8 * hi;
#pragma unroll
            for (int s = 0; s < 4; ++s) ka[s] = *(const bf16x8*)(kp + 16 * s); }
#pragma unroll
        for (int s = 0; s < 4; ++s) S = __builtin_amdgcn_mfma_f32_32x32x16_bf16(ka[s], qf[s], S, 0, 0, 0);
#pragma unroll
        for (int g = 0; g < 4; ++g) { const f32x4 bq = *(const LAS f32x4*)(nd + T * 32 + 8 * g + 4 * hi);
#pragma unroll
            for (int e = 0; e < 4; ++e) { float x = S[4 * g + e] + bq[e]; if (T == 64 && (8 * g + 4 * hi + e) > r32) x = -INFINITY; const float p = __builtin_amdgcn_exp2f(x); S[4 * g + e] = p; lsum += p; } }
        const bf16x8 pa0 = cvt8((f32x4){S[0], S[1], S[2], S[3]}, (f32x4){S[4], S[5], S[6], S[7]}), pa1 = cvt8((f32x4){S[8], S[9], S[10], S[11]}, (f32x4){S[12], S[13], S[14], S[15]});
#pragma unroll 1
        for (int sp = 0; sp < 2; ++sp) {
            bf16x8 vf[2];
            if (T < 64) {
#pragma unroll
                for (int db = 0; db < 2; ++db) { float t[8];
#pragma unroll
                    for (int jj = 0; jj < 8; ++jj) t[jj] = vcache[((cb + (size_t)T * 32 + 16 * sp + 8 * (jj >> 2) + 4 * hi + (jj & 3)) * 16 + h) * 64 + 32 * db + r32];
                    vf[db] = cvt8((f32x4){t[0], t[1], t[2], t[3]}, (f32x4){t[4], t[5], t[6], t[7]}); }
            } else {
#pragma unroll
                for (int db = 0; db < 2; ++db) { bf16x8 t;
#pragma unroll
                    for (int jj = 0; jj < 8; ++jj) t[jj] = (short)Vb[(size_t)(MP + b * DEC_S + 16 * sp + 8 * (jj >> 2) + 4 * hi + (jj & 3)) * DM + h * 64 + 32 * db + r32];
                    vf[db] = t; }
            }
            const bf16x8 pa = sp == 0 ? pa0 : pa1;
            o0 = __builtin_amdgcn_mfma_f32_32x32x16_bf16(pa, vf[0], o0, 0, 0, 0); o1 = __builtin_amdgcn_mfma_f32_32x32x16_bf16(pa, vf[1], o1, 0, 0, 0);
        }
    }
    lsum += bperm(lsum, lane ^ 32);
    if (hi == 0) lp[wid * 32 + r32] = lsum;
#pragma unroll
    for (int r = 0; r < 16; ++r) { op[((wid * 2 + 0) * 16 + r) * 64 + lane] = o0[r]; op[((wid * 2 + 1) * 16 + r) * 64 + lane] = o1[r]; }
    __syncthreads();
    {
        const int i = tid >> 4, d0 = 4 * (tid & 15);
        float l = 0.f;
#pragma unroll
        for (int w = 0; w < 8; ++w) l += lp[w * 32 + i];
        const float rl = 1.0f / l;
        const int hi2 = (i >> 2) & 1, r = (i & 3) + 4 * (i >> 3);
        float acc[4] = {0.f, 0.f, 0.f, 0.f};
#pragma unroll
        for (int w = 0; w < 8; ++w)
#pragma unroll
            for (int e = 0; e < 4; ++e) { const int d = d0 + e; acc[e] += op[((w * 2 + (d >> 5)) * 16 + r) * 64 + (d & 31) + 32 * hi2]; }
        const size_t orow = (size_t)(MP + b * DEC_S + i) * DM + h * 64 + d0;
        const unsigned long long gw8 = *(const unsigned long long*)(OG + orow);
        const unsigned g0 = (unsigned)gw8, g1 = (unsigned)(gw8 >> 32);
        const float y0 = acc[0] * rl * __uint_as_float(g0 << 16), y1 = acc[1] * rl * __uint_as_float(g0 & 0xffff0000u), y2 = acc[2] * rl * __uint_as_float(g1 << 16), y3 = acc[3] * rl * __uint_as_float(g1 & 0xffff0000u);
        *(unsigned long long*)(OUT + orow) = (unsigned long long)pkq(y0, y1) | ((unsigned long long)pkq(y2, y3) << 32);
    }
    __syncthreads();
}
}

namespace ret {
typedef short bf16x8 __attribute__((ext_vector_type(8)));
typedef short s16x4 __attribute__((ext_vector_type(4)));
typedef float f32x16 __attribute__((ext_vector_type(16)));
constexpr int QS = 272, KS = 272, VS = 192, SS = 272;
constexpr int L_Q = 0, L_K = L_Q + 64 * QS, L_V = L_K + 64 * KS, L_VD = L_V + 64 * VS, L_ST = L_VD + 64 * VS, L_CB = L_ST + 64 * SS, L_END = L_CB + 16384;
constexpr int GCH = 16;
__device__ __forceinline__ int crow(int r, int hi) { return (r & 3) + 8 * (r >> 2) + 4 * hi; }
__device__ __forceinline__ s16x4 trd(const LAS unsigned char* p) { return __builtin_bit_cast(s16x4, __builtin_amdgcn_ds_read_tr16_b64_v4i16((LAS v4i16q*)p)); }
__device__ __forceinline__ bf16x8 cat(s16x4 a, s16x4 b) { return (bf16x8){a[0], a[1], a[2], a[3], b[0], b[1], b[2], b[3]}; }
__device__ __forceinline__ u32x4q scale8(u32x4q w, float f) { u32x4q o;
#pragma unroll
    for (int e = 0; e < 4; ++e) o[e] = pkq(__uint_as_float(w[e] << 16) * f, __uint_as_float(w[e] & 0xffff0000u) * f);
    return o; }

template <bool WITH_OUT>
__device__ __forceinline__ void unit(LAS unsigned char* lds, int rowbase, int nch, int n, int h, int dvs, float lg2, const bf16* RQ, const bf16* RK, const bf16* RV, bf16* RO,
                                     const float* Sin, float* Sout) {
    int tid_ = threadIdx.x; asm volatile("" : "+v"(tid_)); const int tid = tid_, lane = tid & 63, wid = __builtin_amdgcn_readfirstlane(tid >> 6);
    const int r32 = lane & 31, hi = lane >> 5, li = lane & 15, grp = (lane >> 4) & 1;
    const int dkb = wid & 3, dvb2 = wid >> 2;
    const int ib = wid & 1, dvb = (wid >> 1) & 1, kq = wid >> 2;
    const int qrow0 = tid >> 4, qch = tid & 15;
    const int vrow = tid >> 3, vch = tid & 7;
    const float vdec = (vrow < n) ? __builtin_amdgcn_exp2f(lg2 * (float)(n - vrow)) : 0.f;
    const float sdec = __builtin_amdgcn_exp2f(lg2 * (float)n);
    f32x16 S;
#pragma unroll
    for (int r = 0; r < 16; ++r) S[r] = Sin ? Sin[(size_t)(32 * dkb + crow(r, hi)) * 256 + dvs * 64 + 32 * dvb2 + r32] : 0.f;
    float gi[16];
    if (WITH_OUT) {
#pragma unroll
        for (int r = 0; r < 16; ++r) gi[r] = __builtin_amdgcn_exp2f(lg2 * (float)(32 * ib + crow(r, hi)));
    }
#define RET_WRITE_ST() do { _Pragma("unroll") for (int g = 0; g < 4; ++g) { const unsigned lo_ = pkq(S[4 * g], S[4 * g + 1]), hh_ = pkq(S[4 * g + 2], S[4 * g + 3]); \
        *(LAS unsigned long long*)(lds + L_ST + (32 * dvb2 + r32) * SS + (32 * dkb + 8 * g + 4 * hi) * 2) = (unsigned long long)lo_ | ((unsigned long long)hh_ << 32); } } while (0)
    if (WITH_OUT) RET_WRITE_ST();
    u32x4q rq[2] = {{0u, 0u, 0u, 0u}, {0u, 0u, 0u, 0u}}, rk[2], rv;
#define RET_GLOAD(c_) do { const size_t tb_ = (size_t)rowbase + (size_t)(c_) * 64; \
        _Pragma("unroll") for (int u = 0; u < 2; ++u) { const int row_ = qrow0 + 32 * u; const bool ok_ = row_ < n; \
            rk[u] = ok_ ? *(const u32x4q*)(RK + (tb_ + row_) * 1024 + h * 128 + qch * 8) : (u32x4q){0u, 0u, 0u, 0u}; \
            if (WITH_OUT) rq[u] = ok_ ? *(const u32x4q*)(RQ + (tb_ + row_) * 1024 + h * 128 + qch * 8) : (u32x4q){0u, 0u, 0u, 0u}; } \
        rv = (vrow < n) ? *(const u32x4q*)(RV + (tb_ + vrow) * 2048 + h * 256 + dvs * 64 + vch * 8) : (u32x4q){0u, 0u, 0u, 0u}; } while (0)
    RET_GLOAD(0);
    for (int c = 0; c < nch; ++c) {
#pragma unroll
        for (int u = 0; u < 2; ++u) { const int row = qrow0 + 32 * u;
            *(LAS u32x4q*)(lds + L_K + row * KS + qch * 16) = rk[u];
            if (WITH_OUT) *(LAS u32x4q*)(lds + L_Q + row * QS + qch * 16) = rq[u]; }
        if (WITH_OUT) *(LAS u32x4q*)(lds + L_V + vrow * VS + vch * 16) = rv;
        *(LAS u32x4q*)(lds + L_VD + vrow * VS + vch * 16) = scale8(rv, vdec);
        if (c + 1 < nch) RET_GLOAD(c + 1);
        __syncthreads();
        if (WITH_OUT) {
            f32x16 X = {};
#pragma unroll
            for (int s = 0; s < 8; ++s) { const bf16x8 a = *(const LAS bf16x8*)(lds + L_K + (32 * kq + r32) * KS + (16 * s + 8 * hi) * 2), bq = *(const LAS bf16x8*)(lds + L_Q + (32 * ib + r32) * QS + (16 * s + 8 * hi) * 2);
                X = __builtin_amdgcn_mfma_f32_32x32x16_bf16(a, bq, X, 0, 0, 0); }
            const int ii = 32 * ib + r32;
#pragma unroll
            for (int r = 0; r < 16; ++r) { const int dj = ii - (32 * kq + crow(r, hi)); X[r] *= __builtin_amdgcn_exp2f(lg2 * (float)(dj < 0 ? -dj : dj)); }
            const u32x4q p0 = {pkq(X[0], X[1]), pkq(X[2], X[3]), pkq(X[4], X[5]), pkq(X[6], X[7])}, p1 = {pkq(X[8], X[9]), pkq(X[10], X[11]), pkq(X[12], X[13]), pkq(X[14], X[15])};
            f32x16 Oa = {};
#pragma unroll
            for (int sp = 0; sp < 2; ++sp) { const LAS unsigned char* vp = lds + L_V + (32 * kq + 16 * sp + 4 * hi + (li >> 2)) * VS + (32 * dvb + 16 * grp + 4 * (li & 3)) * 2;
                const bf16x8 vf = cat(trd(vp), trd(vp + 8 * VS));
                Oa = __builtin_amdgcn_mfma_f32_32x32x16_bf16(__builtin_bit_cast(bf16x8, sp == 0 ? p0 : p1), vf, Oa, 0, 0, 0); }
            f32x16 Ia = {};
#pragma unroll
            for (int s4 = 0; s4 < 4; ++s4) { const int s = 4 * kq + s4;
                const bf16x8 a = *(const LAS bf16x8*)(lds + L_Q + (32 * ib + r32) * QS + (16 * s + 8 * hi) * 2), bs = *(const LAS bf16x8*)(lds + L_ST + (32 * dvb + r32) * SS + (16 * s + 8 * hi) * 2);
                Ia = __builtin_amdgcn_mfma_f32_32x32x16_bf16(a, bs, Ia, 0, 0, 0); }
#pragma unroll
            for (int r = 0; r < 16; ++r) Oa[r] += gi[r] * Ia[r];
            if (kq == 1) {
#pragma unroll
                for (int r = 0; r < 16; ++r) ((LAS float*)(lds + L_CB))[((ib + 2 * dvb) * 16 + r) * 64 + lane] = Oa[r];
            }
#pragma unroll
            for (int r = 0; r < 16; ++r) S[r] *= sdec;
#pragma unroll
            for (int s = 0; s < 4; ++s) { const LAS unsigned char* kp = lds + L_K + (16 * s + 8 * hi + (li >> 2)) * KS + (32 * dkb + 16 * grp + 4 * (li & 3)) * 2;
                const LAS unsigned char* vp = lds + L_VD + (16 * s + 8 * hi + (li >> 2)) * VS + (32 * dvb2 + 16 * grp + 4 * (li & 3)) * 2;
                const bf16x8 ka = cat(trd(kp), trd(kp + 4 * KS)), vb = cat(trd(vp), trd(vp + 4 * VS));
                S = __builtin_amdgcn_mfma_f32_32x32x16_bf16(ka, vb, S, 0, 0, 0); }
            __syncthreads();
            if (kq == 0) {
                const size_t ob = ((size_t)rowbase + (size_t)c * 64) * 2048 + h * 256 + dvs * 64 + 32 * dvb + r32;
#pragma unroll
                for (int r = 0; r < 16; ++r) { const int i = 32 * ib + crow(r, hi); const float v = Oa[r] + ((const LAS float*)(lds + L_CB))[((ib + 2 * dvb) * 16 + r) * 64 + lane];
                    if (i < n) RO[ob + (size_t)i * 2048] = (bf16)(pkq(v, 0.f) & 0xffffu); }
            }
            RET_WRITE_ST();
        } else {
#pragma unroll
            for (int r = 0; r < 16; ++r) S[r] *= sdec;
#pragma unroll
            for (int s = 0; s < 4; ++s) { const LAS unsigned char* kp = lds + L_K + (16 * s + 8 * hi + (li >> 2)) * KS + (32 * dkb + 16 * grp + 4 * (li & 3)) * 2;
                const LAS unsigned char* vp = lds + L_VD + (16 * s + 8 * hi + (li >> 2)) * VS + (32 * dvb2 + 16 * grp + 4 * (li & 3)) * 2;
                const bf16x8 ka = cat(trd(kp), trd(kp + 4 * KS)), vb = cat(trd(vp), trd(vp + 4 * VS));
                S = __builtin_amdgcn_mfma_f32_32x32x16_bf16(ka, vb, S, 0, 0, 0); }
            __syncthreads();
        }
    }
    if (Sout) {
#pragma unroll
        for (int r = 0; r < 16; ++r) Sout[(size_t)(32 * dkb + crow(r, hi)) * 256 + dvs * 64 + 32 * dvb2 + r32] = S[r];
    }
#undef RET_WRITE_ST
#undef RET_GLOAD
}
}
__device__ __forceinline__ float ret_lg2(int h) { return log1pf(-__builtin_amdgcn_exp2f((float)(-5 - h))) * LOG2E; }
__device__ __forceinline__ void ret_scan_phase(float* U, float* outP  , int gtid, int nthreads) {
    for (int e = gtid; e < 16 * 32768; e += nthreads) {
        const int bh = e >> 15, x = e & 32767, h = bh & 7;
        const float dec = __builtin_amdgcn_exp2f(ret_lg2(h) * (float)(ret::GCH * 64));
        float s = 0.f; float* p = U + (size_t)bh * 16 * 32768 + x;
#pragma unroll 4
        for (int sc = 0; sc < 16; ++sc) { const float u = p[(size_t)sc * 32768]; p[(size_t)sc * 32768] = s; s = s * dec + u; }
        outP[e] = s;
    }
}
__device__ __forceinline__ void ret_gn_phase(bf16* RO, const bf16* RG, int gw, int NGW, int lane) {
    for (int m = gw; m < M; m += NGW) {
        const size_t off = (size_t)m * 2048 + (size_t)lane * 32;
        u32x4q w[4], g[4];
#pragma unroll
        for (int j = 0; j < 4; ++j) { w[j] = *(const u32x4q*)(RO + off + 8 * j); g[j] = *(const u32x4q*)(RG + off + 8 * j); }
        float v[32]; float s = 0.f;
#pragma unroll
        for (int j = 0; j < 4; ++j)
#pragma unroll
            for (int e = 0; e < 4; ++e) { v[8 * j + 2 * e] = __uint_as_float(w[j][e] << 16); v[8 * j + 2 * e + 1] = __uint_as_float(w[j][e] & 0xffff0000u); s += v[8 * j + 2 * e] + v[8 * j + 2 * e + 1]; }
        s += bperm(s, lane ^ 1); s += bperm(s, lane ^ 2); s += bperm(s, lane ^ 4);
        const float mu = s * (1.f / 256.f); float q = 0.f;
#pragma unroll
        for (int i = 0; i < 32; ++i) { v[i] -= mu; q += v[i] * v[i]; }
        q += bperm(q, lane ^ 1); q += bperm(q, lane ^ 2); q += bperm(q, lane ^ 4);
        const float rstd = 1.0f / sqrtf(q * (1.f / 256.f) + GN_EPS);
#pragma unroll
        for (int j = 0; j < 4; ++j) { u32x4q o;
#pragma unroll
            for (int e = 0; e < 4; ++e) o[e] = pkq(v[8 * j + 2 * e] * rstd * __uint_as_float(g[j][e] << 16), v[8 * j + 2 * e + 1] * rstd * __uint_as_float(g[j][e] & 0xffff0000u));
            *(u32x4q*)(RO + off + 8 * j) = o; }
    }
}

struct Args { Ptrs P; int ph_lo, ph_hi, li, pad; };
constexpr int N_PHASES = 1 + 8 * 3 + 2 * 4 + 2 * 7 + 1;
#ifndef PHMASK
#define PHMASK 0xffffffffu
#endif
#define EN(k) ((PHMASK >> (k)) & 1u)
#ifndef FOX_PRUNE
#define FOX_PRUNE 0
#endif

__global__ void __launch_bounds__(NWAVES * 64, 2) mega_fwd(Args args) {
    extern __shared__ __attribute__((aligned(16))) unsigned char lds_raw[];
    LAS unsigned char* lds = (LAS unsigned char*)lds_raw;
    const Ptrs& P = args.P;
    const int G = gridDim.x, bx = blockIdx.x;
    const int vcu = (G % 8 == 0) ? (bx % 8) * (G / 8) + bx / 8 : bx;
    const int NGW = G * NWAVES;
    unsigned char* ws = P.ws;
    gu32* ctl = (gu32*)(ws + WS_CTL);
    for (int u = threadIdx.x; u < (LDS_BYTES - LDSCTL_OFF) / 4; u += NWAVES * 64) ((LAS unsigned*)(lds + LDSCTL_OFF))[u] = 0u;
    __syncthreads();
    volatile LAS unsigned* MISC = (volatile LAS unsigned*)(lds + MISC_OFF);
    XcdBarrier bar = xcd_barrier_post((unsigned*)(ctl + CW_BAR) + args.li * XCD_BAR_WORDS, MISC + 8);
    const int lo = args.ph_lo, hi = args.ph_hi;
    int pid = 0;
#define PHASE_BEGIN if (pid >= lo && pid < hi) { int tid = threadIdx.x; asm volatile("" : "+v"(tid)); const int lane = tid & 63, wave = __builtin_amdgcn_readfirstlane(tid >> 6), gw = vcu * NWAVES + wave; (void)lane; (void)gw;
#define PHASE_END   if (pid + 1 < hi) xcd_barrier(bar); } ++pid;

    float* X = (float*)(ws + WS_X); bf16* XN = (bf16*)(ws + WS_XN);
    const float* xsOff = P.x_sample - (size_t)MP * DM;

    PHASE_BEGIN if (EN(0)) p0_prologue(P, lds, gw, NGW, wave, lane); PHASE_END

    for (int s = 0; s < 8; ++s) {
        const int layer = s >> 1, half = s & 1, jl = layer >> 1;
        const float* gains = P.norm_gains + (size_t)layer * 3 * DM;
        const float* xinP = (s == 0) ? P.x_prompt : X; const float* xinS = (s == 0) ? xsOff : X;
        PHASE_BEGIN if (EN(1)) norm_phase<false>(xinP, xinS, gains + (half ? 2 * DM : 0), XN, nullptr, nullptr, nullptr, nullptr, nullptr, lds, gw, NGW, tid, lane); PHASE_END
        PHASE_BEGIN if (EN(2)) {
            pg8::Gemm g{XN, (const bf16*)(ws + WS_WFI + (size_t)s * WFI_STRIDE), M, 2 * FF, DM}; pg8::StaticOrder S; S.init(M, 2 * FF, G, bx);
            pg8::EpiSwiglu E{(bf16*)(ws + WS_ACT), FF};
            pg8::gemm_phase<pg8::EpiSwiglu, pg8::StaticOrder, true, true, DM>(lds + RING_OFF, g, S, E);
        } PHASE_END
        PHASE_BEGIN if (EN(3)) {
            pg8::Gemm g{(const bf16*)(ws + WS_ACT), (const bf16*)(ws + WS_WFO + (size_t)s * WFO_STRIDE), M, DM, FF}; pg8::StaticOrder S; S.init(M, DM, G, bx);
            pg8::EpiResid E{xinP, xinS, X, 0.5f};
            pg8::gemm_phase<pg8::EpiResid, pg8::StaticOrder, true, true, FF>(lds + RING_OFF, g, S, E);
        } PHASE_END
        if (half == 0) {
            if ((layer & 1) == 0) {
                float* LOGF = (float*)(ws + WS_LOGF); float* ND = (float*)(ws + WS_ND);
                bf16 *Qb = (bf16*)(ws + WS_Q), *Kb = (bf16*)(ws + WS_K), *Vb = (bf16*)(ws + WS_V), *OGb = (bf16*)(ws + WS_OG);
                PHASE_BEGIN if (EN(4)) norm_phase<true>(X, X, gains + DM, XN, (const float*)(ws + WS_WF) + (size_t)jl * 16 * 1024, P.fox_b_f + jl * 16, LOGF,
                                             P.out + O_FLP + (size_t)jl * MP * 16, P.out + O_FLS + (size_t)jl * MS * 16, lds, gw, NGW, tid, lane); PHASE_END
                PHASE_BEGIN if (EN(5)) {
                    if (vcu < 32) cumsum_unit(LOGF, ND, vcu, lds, tid, wave, lane);
                    pg8::Gemm g{XN, (const bf16*)(ws + WS_WXI + (size_t)jl * WXI_STRIDE), M, 4096, DM}; pg8::StaticOrder S; S.init(M, 4096, G, bx);
                    pg8::EpiFoxProj E{Qb, Kb, Vb, OGb, P.out + O_FKP + (size_t)jl * MP * DM, P.out + O_FVP + (size_t)jl * MP * DM, P.out + O_FKS + (size_t)jl * MS * DM, P.out + O_FVS + (size_t)jl * MS * DM,
                                      P.fox_qg + jl * 64, P.fox_kg + jl * 64, attn_body::C2};
                    pg8::gemm_phase<pg8::EpiFoxProj, pg8::StaticOrder, true, true, DM>(lds + RING_OFF, g, S, E);
                } PHASE_END
                PHASE_BEGIN if (EN(6)) {
                    float thr_off = 0.f;
                    if (FOX_PRUNE) { int tl_ = threadIdx.x; asm volatile("" : "+v"(tl_)); const int lane = tl_ & 63; const float mq = wave_max(fabsf(P.fox_qg[jl * 64 + lane]), lane), mk = wave_max(fabsf(P.fox_kg[jl * 64 + lane]), lane); thr_off = 60.f + 2.f * (8.f * mq * mk * LOG2E); }
                    for (int L = vcu; L < 2048; L += G) {
                        const int i = L >> 8, c = L & 255, bh = c >> 3, sl = c & 7;
                        const int qb = (i & 1) ? (16 * (i >> 1) + 15 - sl) : (16 * (i >> 1) + sl);
                        int t0 = 0;
                        if (FOX_PRUNE) {
                            int tl_ = threadIdx.x; asm volatile("" : "+v"(tl_)); const int lane = tl_ & 63;
                            const float* ndh = ND + (size_t)bh * SEQ; const int ntf = 4 * qb + 4; const float thr = ndh[qb * 256] - thr_off;
                            int cnt = 0;
#pragma unroll
                            for (int k = 0; k < 4; ++k) { const int t = lane + 64 * k; const bool skip = (t < ntf) && (ndh[t * 64 + 63] <= thr); cnt += __popcll(__ballot(skip)); }
                            t0 = cnt & ~1; if (t0 > ntf - 4) t0 = ntf - 4;
                            t0 = __builtin_amdgcn_readfirstlane(t0);
                        }
                        attn_body::attn_unit<8>(bh >> 4, bh & 15, qb, t0, (const attn_body::bf16*)Qb, (const attn_body::bf16*)Kb, (const attn_body::bf16*)Vb, (const attn_body::bf16*)OGb, ND,
                                                (attn_body::bf16*)Qb, (char*)lds_raw + RING_OFF);
                    }
                    if (EN(7)) for (int L = vcu; L < DEC_B * 16; L += G)
                        smp::unit(jl, L >> 4, L & 15, P.cache_k, P.cache_v, P.cache_lf, LOGF, Qb, Kb, Vb, OGb, Qb, lds + RING_OFF);
                } PHASE_END
                PHASE_BEGIN if (EN(8)) {
                    pg8::Gemm g{Qb, (const bf16*)(ws + WS_WXO + (size_t)jl * WXO_STRIDE), M, DM, DM}; pg8::StaticOrder S; S.init(M, DM, G, bx);
                    pg8::EpiResid E{X, X, X, 1.0f};
                    pg8::gemm_phase<pg8::EpiResid, pg8::StaticOrder, true, true, DM>(lds + RING_OFF, g, S, E);
                } PHASE_END
            } else {
                bf16 *RQ = (bf16*)(ws + WS_RQ), *RK = (bf16*)(ws + WS_RK), *RV = (bf16*)(ws + WS_RV), *RG = (bf16*)(ws + WS_RG), *RO = (bf16*)(ws + WS_RO);
                float* U = (float*)(ws + WS_U);
                PHASE_BEGIN if (EN(9)) norm_phase<false>(X, X, gains + DM, XN, nullptr, nullptr, nullptr, nullptr, nullptr, lds, gw, NGW, tid, lane); PHASE_END
                PHASE_BEGIN if (EN(10)) {
                    pg8::Gemm g{XN, (const bf16*)(ws + WS_WRI + (size_t)jl * WRI_STRIDE), M, 6144, DM}; pg8::StaticOrder S; S.init(M, 6144, G, bx);
                    pg8::EpiRetProj E{RQ, RK, RV, RG};
                    pg8::gemm_phase<pg8::EpiRetProj, pg8::StaticOrder, true, true, DM>(lds + RING_OFF, g, S, E);
                } PHASE_END
                PHASE_BEGIN if (EN(11)) {
                    for (int L = vcu; L < 1024; L += G) { const int bh = L >> 6, sc = (L >> 2) & 15, dvs = L & 3, b = bh >> 3, h = bh & 7;
                        ret::unit<false>(lds + RING_OFF, b * SEQ + sc * (ret::GCH * 64), ret::GCH, 64, h, dvs, ret_lg2(h), RQ, RK, RV, RO, nullptr, U + (size_t)(bh * 16 + sc) * 32768); }
                } PHASE_END
                PHASE_BEGIN if (EN(12)) ret_scan_phase(U, P.out + O_RP + (size_t)jl * 16 * 32768, gw * 64 + lane, NGW * 64); PHASE_END
                PHASE_BEGIN if (EN(13)) {
                    for (int L = vcu; L < 1024; L += G) { const int bh = L >> 6, sc = (L >> 2) & 15, dvs = L & 3, b = bh >> 3, h = bh & 7;
                        ret::unit<true>(lds + RING_OFF, b * SEQ + sc * (ret::GCH * 64), ret::GCH, 64, h, dvs, ret_lg2(h), RQ, RK, RV, RO, U + (size_t)(bh * 16 + sc) * 32768, nullptr); }
                    for (int L = vcu; L < 512; L += G) { const int b = L >> 5, h = (L >> 2) & 7, dvs = L & 3;
                        ret::unit<true>(lds + RING_OFF, MP + b * DEC_S, 1, DEC_S, h, dvs, ret_lg2(h), RQ, RK, RV, RO, P.state_ret + ((size_t)(jl * DEC_B + b) * 8 + h) * 32768,
                                        P.out + O_RS + ((size_t)(jl * DEC_B + b) * 8 + h) * 32768); }
                } PHASE_END
                PHASE_BEGIN if (EN(14)) ret_gn_phase(RO, RG, gw, NGW, lane); PHASE_END
                PHASE_BEGIN if (EN(15)) {
                    pg8::Gemm g{RO, (const bf16*)(ws + WS_WRO + (size_t)jl * WRO_STRIDE), M, DM, 2048}; pg8::StaticOrder S; S.init(M, DM, G, bx);
                    pg8::EpiResid E{X, X, X, 1.0f};
                    pg8::gemm_phase<pg8::EpiResid, pg8::StaticOrder, true, true, 2048>(lds + RING_OFF, g, S, E);
                } PHASE_END
            }
        }
    }
    PHASE_BEGIN if (EN(16)) final_norm_phase(X, P.final_gain, P.out + O_YP, P.out + O_YS, gw, NGW, lane); PHASE_END
#undef PHASE_BEGIN
#undef PHASE_END
}

#ifndef MK_N_LAUNCHES
#define MK_N_LAUNCHES 1
#endif
extern "C" void kernel_launch(void* const* d_in, const int* in_sizes, int n_in, void* d_out, int out_size, void* d_ws, size_t ws_size, hipStream_t stream) {
    static int grid = 0;
    if (grid == 0) {
        if (n_in != 17 || (size_t)out_size != O_END || ws_size < WS_END) { fprintf(stderr, "kernel_launch: built for 17 inputs, %zu outputs, >= %zu bytes of workspace; got n_in %d, out %d, ws %zu; nothing launched\n", (size_t)O_END, (size_t)WS_END, n_in, out_size, ws_size); grid = -1; return; }
        int dev = 0, cus = 0, per_cu = 0;
        if (hipGetDevice(&dev) != hipSuccess || hipDeviceGetAttribute(&cus, hipDeviceAttributeMultiprocessorCount, dev) != hipSuccess) { fprintf(stderr, "kernel_launch: device query failed\n"); grid = -1; return; }
        if (hipFuncSetAttribute((const void*)mega_fwd, hipFuncAttributeMaxDynamicSharedMemorySize, LDS_BYTES) != hipSuccess) { fprintf(stderr, "kernel_launch: hipFuncSetAttribute failed\n"); grid = -1; return; }
        if (hipOccupancyMaxActiveBlocksPerMultiprocessor(&per_cu, (const void*)mega_fwd, NWAVES * 64, LDS_BYTES) != hipSuccess || per_cu < 1)
            fprintf(stderr, "kernel_launch: note: occupancy query reports %d workgroups per CU\n", per_cu);
        (void)hipGetLastError();
        grid = cus;
    }
    if (grid < 0) return;
    if (hipMemsetAsync((char*)d_ws + WS_CTL, 0, CTL_ZERO_BYTES, stream) != hipSuccess) { fprintf(stderr, "kernel_launch: memset failed\n"); return; }
    Args a{};
    const float** pp = (const float**)&a.P;
    for (int i = 0; i < 17; ++i) pp[i] = (const float*)d_in[i];
    a.P.out = (float*)d_out; a.P.ws = (unsigned char*)d_ws;
    const int NL = MK_N_LAUNCHES;
    for (int li = 0; li < NL; ++li) {
        a.ph_lo = (int)((long)N_PHASES * li / NL); a.ph_hi = (int)((long)N_PHASES * (li + 1) / NL); a.li = li; a.pad = 0;
        hipLaunchKernelGGL(mega_fwd, dim3(grid), dim3(NWAVES * 64), LDS_BYTES, stream, a);
        const hipError_t le = hipPeekAtLastError();
        if (le != hipSuccess) { fprintf(stderr, "kernel_launch: launch %d failed: %s\n", li, hipGetErrorName(le)); break; }
    }
}
```

```cpp
#include <hip/hip_runtime.h>
#include <hip/hip_bf16.h>
#include <cstdio>
#include <cstdint>
#include <cmath>
#define FOX_PRUNE 1
#define FOX_PRUNE_T 40.f
#ifndef EPI_SEL
#define EPI_SEL 0
#endif
namespace pg8 {
#define PG8_LAS __attribute__((address_space(3)))
typedef unsigned short bf16_t;
typedef short bf16x8 __attribute__((ext_vector_type(8)));
typedef float f32x4 __attribute__((ext_vector_type(4)));
typedef unsigned u32x4 __attribute__((ext_vector_type(4)));
constexpr int BM = 256, BK = 64, HALF = 128, HTB = HALF * BK * 2  , STAGE_BYTES = 8 * HTB, NXCD = 8, WGM = 8;

__host__ __device__ __forceinline__ int lds_byte(int r, int c) { const int st = (r >> 4) * 2 + (c >> 5), rr = r & 15, cc = c & 31, ob = rr * 64 + cc * 2; return st * 1024 + (ob ^ (((ob >> 9) & 1) << 5)); }
__host__ __device__ __forceinline__ void stage_rc(int b, int& R, int& C) { const int st = b / 1024, sb = b % 1024, swz = sb ^ (((sb >> 9) & 1) << 5); R = (st >> 1) * 16 + swz / 64; C = (st & 1) * 32 + (swz % 64) / 2; }
__host__ __device__ __forceinline__ int perm32(int rho) { const int n = rho >> 4, i = rho & 15; return 8 * (i >> 2) + 4 * n + (i & 3); }

__host__ __device__ __forceinline__ int perm32inv(int x) { return 16 * ((x >> 2) & 1) + 4 * (x >> 3) + (x & 3); }
__host__ __device__ __forceinline__ size_t pk_elem(int row, int k, int nt) { return ((size_t)((row >> 8) * nt + (k >> 6)) * 2 + ((row >> 7) & 1)) * (size_t)(HTB / 2) + (size_t)(lds_byte(row & 127, k & 63) >> 1); }
__host__ __device__ __forceinline__ int pk_slot(int n) { return (n & ~31) + perm32inv(n & 31); }

struct Unit { int pm, pn, ord; };
struct Gemm { const bf16_t* A; const bf16_t* Bt; int M, N, K; };

struct StaticOrder {
    int nM, nN, nwg, G, c;
    __host__ __device__ void init(int M, int N, int G_, int c_) { nM = M / BM; nN = N / BM; nwg = nM * nN; G = G_; c = c_; }
    __host__ __device__ bool next(int i, Unit& u) const {
        const long L = (long)i * G + c; if (L >= nwg) return false;
        int wgid = (int)L; { const int q = nwg / NXCD, r = nwg % NXCD, xcd = wgid % NXCD, off = wgid / NXCD; wgid = (xcd < r ? xcd * (q + 1) : r * (q + 1) + (xcd - r) * q) + off; }
        const int nig = WGM * nN, gid = wgid / nig, fm = gid * WGM, gsz = (nM - fm) < WGM ? (nM - fm) : WGM;
        u.pm = fm + ((wgid % nig) % gsz); u.pn = (wgid % nig) / gsz; u.ord = i; return true;
    }
    __device__ __forceinline__ void a_ready(const Unit&) const {}
    __device__ __forceinline__ void done(const Unit&) const {}
};

__device__ __forceinline__ unsigned cvt_pk_bf16(float lo, float hi) { unsigned r; asm volatile("v_cvt_pk_bf16_f32 %0, %1, %2" : "=v"(r) : "v"(lo), "v"(hi)); return r; }
typedef float f32x2 __attribute__((ext_vector_type(2)));
constexpr int EP_MP = 32768;
__device__ __forceinline__ unsigned pk_bf16(float lo, float hi) { typedef float f2 __attribute__((ext_vector_type(2))); typedef __bf16 b2 __attribute__((ext_vector_type(2))); f2 v = {lo, hi}; b2 b = __builtin_convertvector(v, b2); return __builtin_bit_cast(unsigned, b); }
__device__ __forceinline__ u32x4 pk8(const f32x4 a, const f32x4 b) { u32x4 w; w.x = pk_bf16(a[0], a[1]); w.y = pk_bf16(a[2], a[3]); w.z = pk_bf16(b[0], b[1]); w.w = pk_bf16(b[2], b[3]); return w; }
__device__ __forceinline__ float sigmoidf_fast(float x) { return __builtin_amdgcn_rcpf(1.0f + __builtin_amdgcn_exp2f(-1.4426950408889634f * x)); }

constexpr int RSB_MAX_UNITS = 14;
template <class Sched>
__device__ __forceinline__ void rstd_prologue(const Sched& S, const float* SSQP, const float* SSQS, PG8_LAS float* rsb, int tid) {
    const int r = tid >> 1, hf = tid & 1, lane = tid & 63;
    f32x4 pa[RSB_MAX_UNITS], pb[RSB_MAX_UNITS]; int kind[RSB_MAX_UNITS];
#pragma unroll
    for (int i = 0; i < RSB_MAX_UNITS; ++i) { Unit u; kind[i] = 0; pa[i] = (f32x4){0.f, 0.f, 0.f, 0.f}; pb[i] = pa[i];
        if (S.next(i, u)) { const int row = u.pm * BM + r;
            if (row < EP_MP) { const float* q = SSQP + (size_t)row * 16 + 8 * hf; pa[i] = *(const f32x4*)q; pb[i] = *(const f32x4*)(q + 4); kind[i] = 1; } else kind[i] = 2 + (u.pm - EP_MP / BM); } }
#pragma unroll
    for (int i = 0; i < RSB_MAX_UNITS; ++i) {
        if (kind[i] == 0) continue;
        float s = ((pa[i][0] + pa[i][1]) + (pa[i][2] + pa[i][3])) + ((pb[i][0] + pb[i][1]) + (pb[i][2] + pb[i][3]));
        if (kind[i] >= 2) { const float* q = SSQS + (size_t)((kind[i] - 2) * BM + r) * 64 + 32 * hf; s = 0.f;
#pragma unroll
            for (int k = 0; k < 8; ++k) { const f32x4 a = *(const f32x4*)(q + 4 * k); s += (a[0] + a[1]) + (a[2] + a[3]); } }
        s += __int_as_float(__builtin_amdgcn_ds_bpermute((lane ^ 1) << 2, __float_as_int(s)));
        if (hf == 0) rsb[i * 256 + r] = __builtin_amdgcn_rsqf(s * (1.0f / 1024.0f) + 1e-6f);
    }
    __syncthreads();
}
template <class Sched>
struct RstdHook { const Sched& S; const float* SSQP; const float* SSQS; PG8_LAS float* rsb;
    __device__ __forceinline__ void operator()(int tid) const { rstd_prologue(S, SSQP, SSQS, rsb, tid); } };
__device__ __forceinline__ void rows_rstd(float (&rs)[2][4], const PG8_LAS float* rsb, const Unit& u, int wr, int fr) {
#pragma unroll
    for (int ai = 0; ai < 2; ++ai)
#pragma unroll
        for (int m = 0; m < 4; ++m) rs[ai][m] = rsb[u.ord * 256 + ai * HALF + wr * 64 + m * 16 + fr];
}
struct EpiSwiglu {
    static constexpr bool PERM = true, AFTER_DRAIN = false, INIT = false, IDEMP = (EPI_SEL == 0);
    bf16_t* O; int ldc; const PG8_LAS float* rsb;
    __device__ __forceinline__ void operator()(const f32x4 (&acc)[2][2][4][2], const Unit& u, int wr, int wc, int fr, int fq) const {
        const int row0 = u.pm * BM + wr * 64 + fr, col0 = u.pn * 128 + wc * 32 + 8 * fq;
        float rsa[2][4]; rows_rstd(rsa, rsb, u, wr, fr);
#pragma unroll
        for (int ai = 0; ai < 2; ++ai)
#pragma unroll
            for (int m = 0; m < 4; ++m) {
                f32x4 h[2]; const float rs = rsa[ai][m], c1 = -1.4426950408889634f * rs, rs2 = rs * rs;
#pragma unroll
                for (int n = 0; n < 2; ++n) { const f32x4 g = acc[ai][0][m][n], uu = acc[ai][1][m][n]; const f32x4 t = g * c1; f32x4 d, r;
#pragma unroll
                    for (int e = 0; e < 4; ++e) d[e] = __builtin_amdgcn_exp2f(t[e]);
                    d = d + 1.0f;
#pragma unroll
                    for (int e = 0; e < 4; ++e) r[e] = __builtin_amdgcn_rcpf(d[e]);
                    h[n] = (g * uu) * (r * rs2); }
                *(u32x4*)(O + pk_elem(row0 + ai * HALF + m * 16, col0, ldc >> 6)) = pk8(h[0], h[1]);
            }
    }
    __device__ __forceinline__ void rowgrp(const f32x4 (&v)[2][2], int row, float rs, int pn, int wc, int fr, int fq) const {
        f32x4 h[2];
#pragma unroll
        for (int n = 0; n < 2; ++n) { const f32x4 g = v[0][n] * rs, uu = v[1][n] * rs;
#pragma unroll
            for (int e = 0; e < 4; ++e) h[n][e] = g[e] * uu[e] * sigmoidf_fast(g[e]); }
        *(u32x4*)(O + pk_elem(row, pn * 128 + wc * 32 + 8 * fq, ldc >> 6)) = pk8(h[0], h[1]);
    }
};
struct EpiResid {
    static constexpr bool PERM = true, AFTER_DRAIN = false, INIT = false, IDEMP = false;
    bf16_t* X; float s; float* SSQ;
    __device__ __forceinline__ void init(f32x4 (&acc)[2][2][4][2], const Unit& u, int wr, int wc, int fr, int fq) const {}
    __device__ __forceinline__ void operator()(const f32x4 (&acc)[2][2][4][2], const Unit& u, int wr, int wc, int fr, int fq) const {
        const int row0 = u.pm * BM + wr * 64 + fr;
        bf16_t* xb = X + pk_elem(row0, u.pn * BM + wc * 32 + 8 * fq, 16);
        u32x4 b[2][4][2];
#pragma unroll
        for (int ai = 0; ai < 2; ++ai)
#pragma unroll
            for (int m = 0; m < 4; ++m)
#pragma unroll
                for (int bj = 0; bj < 2; ++bj) b[ai][m][bj] = *(const u32x4*)(xb + 8192 * ai + 1024 * m + 32768 * bj);
#pragma unroll
        for (int ai = 0; ai < 2; ++ai) {
#pragma unroll
            for (int m = 0; m < 4; ++m) { float ss = 0.f;
#pragma unroll
                for (int bj = 0; bj < 2; ++bj) { const u32x4 w = b[ai][m][bj]; const f32x4 a0 = acc[ai][bj][m][0] * s, a1 = acc[ai][bj][m][1] * s;
                    const f32x4 v0 = {__uint_as_float(w.x << 16) + a0[0], __uint_as_float(w.x & 0xffff0000u) + a0[1], __uint_as_float(w.y << 16) + a0[2], __uint_as_float(w.y & 0xffff0000u) + a0[3]};
                    const f32x4 v1 = {__uint_as_float(w.z << 16) + a1[0], __uint_as_float(w.z & 0xffff0000u) + a1[1], __uint_as_float(w.w << 16) + a1[2], __uint_as_float(w.w & 0xffff0000u) + a1[3]};
                    ss += ((v0[0] * v0[0] + v0[1] * v0[1]) + (v0[2] * v0[2] + v0[3] * v0[3])) + ((v1[0] * v1[0] + v1[1] * v1[1]) + (v1[2] * v1[2] + v1[3] * v1[3]));
                    *(u32x4*)(xb + 8192 * ai + 1024 * m + 32768 * bj) = pk8(v0, v1); }
                ss += __int_as_float(__builtin_amdgcn_ds_bpermute((fr + 16 * (fq ^ 1)) << 2, __float_as_int(ss)));
                ss += __int_as_float(__builtin_amdgcn_ds_bpermute((fr + 16 * (fq ^ 2)) << 2, __float_as_int(ss)));
                if (fq == 0) SSQ[(size_t)(row0 + ai * HALF + m * 16) * 16 + 4 * u.pn + wc] = ss; }
        }
    }
};
struct EpiFoxProj {
    static constexpr bool PERM = true, AFTER_DRAIN = false, INIT = false, IDEMP = (EPI_SEL == 1);
    bf16_t *Q, *K, *V, *OG;
    float *kP, *vP, *kS, *vS;
    const PG8_LAS float* gl;
    const PG8_LAS float* rsb;
    float qscale;
    template <int KIND  >
    __device__ __forceinline__ void rows(const f32x4 (&acc)[2][2][4][2], const f32x4 (&gn)[2][2], const float (&rsa)[2][4], int row0, int colh, int fr, int fq) const {
        bf16_t* dstb = (KIND == 0) ? Q : (KIND == 1) ? K : (KIND == 2) ? V : OG;
#pragma unroll
        for (int ai = 0; ai < 2; ++ai)
#pragma unroll
            for (int m = 0; m < 4; ++m) {
                const int row = row0 + ai * HALF + m * 16;
                f32x4 v[2][2];
#pragma unroll
                for (int bj = 0; bj < 2; ++bj)
#pragma unroll
                    for (int n = 0; n < 2; ++n) v[bj][n] = acc[ai][bj][m][n] * rsa[ai][m];
                if (KIND <= 1) {
                    float ss = 0.f;
#pragma unroll
                    for (int bj = 0; bj < 2; ++bj)
#pragma unroll
                        for (int n = 0; n < 2; ++n) { const f32x4 x = v[bj][n]; ss += (x[0] * x[0] + x[1] * x[1]) + (x[2] * x[2] + x[3] * x[3]); }
                    ss += __int_as_float(__builtin_amdgcn_ds_bpermute((fr + 16 * (fq ^ 1)) << 2, __float_as_int(ss))); ss += __int_as_float(__builtin_amdgcn_ds_bpermute((fr + 16 * (fq ^ 2)) << 2, __float_as_int(ss)));
                    float rinv = __builtin_amdgcn_rsqf(ss * (1.0f / 64.0f) + 1e-6f); if (KIND == 0) rinv *= qscale;
#pragma unroll
                    for (int bj = 0; bj < 2; ++bj)
#pragma unroll
                        for (int n = 0; n < 2; ++n) v[bj][n] = v[bj][n] * rinv * gn[bj][n];
                } else if (KIND == 3) {
#pragma unroll
                    for (int bj = 0; bj < 2; ++bj)
#pragma unroll
                        for (int n = 0; n < 2; ++n)
#pragma unroll
                            for (int e = 0; e < 4; ++e) v[bj][n][e] = sigmoidf_fast(v[bj][n][e]);
                }
                bf16_t* rp = dstb + (size_t)row * 1024 + colh;
#pragma unroll
                for (int bj = 0; bj < 2; ++bj) *(u32x4*)(rp + 32 * bj) = pk8(v[bj][0], v[bj][1]);
                if ((KIND == 1 || KIND == 2) && kP != nullptr) {
                    float* o = (row < EP_MP) ? ((KIND == 1 ? kP : vP) + (size_t)row * 1024) : ((KIND == 1 ? kS : vS) + (size_t)(row - EP_MP) * 1024);
                    o += colh;
#pragma unroll
                    for (int bj = 0; bj < 2; ++bj)
#pragma unroll
                        for (int n = 0; n < 2; ++n) *(f32x4*)(o + 32 * bj + 4 * n) = v[bj][n];
                }
            }
    }
    template <int KIND>
    __device__ __forceinline__ void rowgrp1(const f32x4 (&a)[2][2], const f32x4 (&gn)[2][2], float rs, int row, int colh, int fr, int fq) const {
        bf16_t* dstb = (KIND == 0) ? Q : (KIND == 1) ? K : (KIND == 2) ? V : OG;
        f32x4 v[2][2];
#pragma unroll
        for (int bj = 0; bj < 2; ++bj)
#pragma unroll
            for (int n = 0; n < 2; ++n) v[bj][n] = a[bj][n] * rs;
        if (KIND <= 1) {
            float ss = 0.f;
#pragma unroll
            for (int bj = 0; bj < 2; ++bj)
#pragma unroll
                for (int n = 0; n < 2; ++n) { const f32x4 x = v[bj][n]; ss += (x[0] * x[0] + x[1] * x[1]) + (x[2] * x[2] + x[3] * x[3]); }
            ss += __int_as_float(__builtin_amdgcn_ds_bpermute((fr + 16 * (fq ^ 1)) << 2, __float_as_int(ss))); ss += __int_as_float(__builtin_amdgcn_ds_bpermute((fr + 16 * (fq ^ 2)) << 2, __float_as_int(ss)));
            float rinv = __builtin_amdgcn_rsqf(ss * (1.0f / 64.0f) + 1e-6f); if (KIND == 0) rinv *= qscale;
#pragma unroll
            for (int bj = 0; bj < 2; ++bj)
#pragma unroll
                for (int n = 0; n < 2; ++n) v[bj][n] = v[bj][n] * rinv * gn[bj][n];
        } else if (KIND == 3) {
#pragma unroll
            for (int bj = 0; bj < 2; ++bj)
#pragma unroll
                for (int n = 0; n < 2; ++n)
#pragma unroll
                    for (int e = 0; e < 4; ++e) v[bj][n][e] = sigmoidf_fast(v[bj][n][e]);
        }
        bf16_t* rp = dstb + (size_t)row * 1024 + colh;
#pragma unroll
        for (int bj = 0; bj < 2; ++bj) *(u32x4*)(rp + 32 * bj) = pk8(v[bj][0], v[bj][1]);
    }
    __device__ __forceinline__ void rowgrp(const f32x4 (&v)[2][2], int row, float rs, int pn, int wc, int fr, int fq) const {
        const int seg = pn >> 2, head = 4 * (pn & 3) + wc, colh = head * 64 + 8 * fq;
        f32x4 gn[2][2];
        const PG8_LAS float* gp = gl + ((seg == 1) ? 64 : 0);
#pragma unroll
        for (int bj = 0; bj < 2; ++bj)
#pragma unroll
            for (int n = 0; n < 2; ++n) gn[bj][n] = *(const PG8_LAS f32x4*)(gp + 32 * bj + 8 * fq + 4 * n);
        if (seg == 0) rowgrp1<0>(v, gn, rs, row, colh, fr, fq);
        else if (seg == 1) rowgrp1<1>(v, gn, rs, row, colh, fr, fq);
        else if (seg == 2) rowgrp1<2>(v, gn, rs, row, colh, fr, fq);
        else rowgrp1<3>(v, gn, rs, row, colh, fr, fq);
    }
    __device__ __forceinline__ void operator()(const f32x4 (&acc)[2][2][4][2], const Unit& u, int wr, int wc, int fr, int fq) const {
        const int seg = u.pn >> 2, head = 4 * (u.pn & 3) + wc;
        const int row0 = u.pm * BM + wr * 64 + fr, colh = head * 64 + 8 * fq;
        f32x4 gn[2][2];
        const PG8_LAS float* gp = gl + ((seg == 1) ? 64 : 0);
#pragma unroll
        for (int bj = 0; bj < 2; ++bj)
#pragma unroll
            for (int n = 0; n < 2; ++n) gn[bj][n] = *(const PG8_LAS f32x4*)(gp + 32 * bj + 8 * fq + 4 * n);
        float rsa[2][4]; rows_rstd(rsa, rsb, u, wr, fr);
        if (seg == 0) rows<0>(acc, gn, rsa, row0, colh, fr, fq);
        else if (seg == 1) rows<1>(acc, gn, rsa, row0, colh, fr, fq);
        else if (seg == 2) rows<2>(acc, gn, rsa, row0, colh, fr, fq);
        else rows<3>(acc, gn, rsa, row0, colh, fr, fq);
    }
};
struct EpiRetProj {
    static constexpr bool PERM = true, AFTER_DRAIN = false, INIT = false, IDEMP = (EPI_SEL == 2);
    bf16_t *RQ, *RK, *RV, *RG;
    const PG8_LAS float* rsb;
    __device__ __forceinline__ void operator()(const f32x4 (&acc)[2][2][4][2], const Unit& u, int wr, int wc, int fr, int fq) const {
        const int pn = u.pn, row0 = u.pm * BM + wr * 64 + fr;
        float rsa[2][4]; rows_rstd(rsa, rsb, u, wr, fr);
        if (pn < 8) {
            const int seg = pn >> 2, head = 2 * (pn & 3) + (wc >> 1), j0 = 32 * (wc & 1) + 8 * fq;
            float invf[2][4];
#pragma unroll
            for (int n = 0; n < 2; ++n)
#pragma unroll
                for (int e = 0; e < 4; ++e) invf[n][e] = __builtin_amdgcn_exp2f(-(float)(j0 + 4 * n + e) * (13.287712379549449f / 63.0f));
            const float ksc = (seg == 1) ? 0.08838834764831845f : 1.0f;
            bf16_t* dst = (seg == 0 ? RQ : RK);
#pragma unroll
            for (int ai = 0; ai < 2; ++ai)
#pragma unroll
                for (int m = 0; m < 4; ++m) {
                    const int row = row0 + ai * HALF + m * 16;
                    const float pos = (float)((row < EP_MP) ? (row & 16383) : (2048 + ((row - EP_MP) & 31)));
                    f32x4 o1[2], o2[2];
#pragma unroll
                    for (int n = 0; n < 2; ++n)
#pragma unroll
                        for (int e = 0; e < 4; ++e) {
                            const float ang = pos * invf[n][e];
                            const float nr = __builtin_rintf(ang * 0.15915493667125702f);
                            const float rev = __builtin_fmaf(ang, 0.15915493667125702f, -nr) + ang * 6.4206382432985265e-09f;
                            const float sn = __builtin_amdgcn_sinf(rev), cs = __builtin_amdgcn_cosf(rev);
                            const float x1 = acc[ai][0][m][n][e] * (ksc * rsa[ai][m]), x2 = acc[ai][1][m][n][e] * (ksc * rsa[ai][m]);
                            o1[n][e] = x1 * cs - x2 * sn; o2[n][e] = x1 * sn + x2 * cs;
                        }
                    bf16_t* rp = dst + (size_t)row * 1024 + head * 128 + j0;
                    *(u32x4*)(rp) = pk8(o1[0], o1[1]); *(u32x4*)(rp + 64) = pk8(o2[0], o2[1]);
                }
        } else {
            const bool isg = pn >= 16; bf16_t* dst = isg ? RG : RV;
            const int col0 = 256 * ((pn - 8) & 7) + wc * 32 + 8 * fq;
#pragma unroll
            for (int ai = 0; ai < 2; ++ai)
#pragma unroll
                for (int m = 0; m < 4; ++m) {
                    bf16_t* rp = dst + (size_t)(row0 + ai * HALF + m * 16) * 2048 + col0;
#pragma unroll
                    for (int bj = 0; bj < 2; ++bj) { f32x4 a = acc[ai][bj][m][0] * rsa[ai][m], b = acc[ai][bj][m][1] * rsa[ai][m];
                        if (isg) {
#pragma unroll
                            for (int e = 0; e < 4; ++e) { a[e] = a[e] * sigmoidf_fast(a[e]); b[e] = b[e] * sigmoidf_fast(b[e]); } }
                        *(u32x4*)(rp + bj * HALF) = pk8(a, b); }
                }
        }
    }
    __device__ __forceinline__ void rowgrp(const f32x4 (&v)[2][2], int row, float rs, int pn, int wc, int fr, int fq) const {
        if (pn < 8) {
            const int seg = pn >> 2, head = 2 * (pn & 3) + (wc >> 1), j0 = 32 * (wc & 1) + 8 * fq;
            const float ksc = ((seg == 1) ? 0.08838834764831845f : 1.0f) * rs;
            const float pos = (float)((row < EP_MP) ? (row & 16383) : (2048 + ((row - EP_MP) & 31)));
            f32x4 o1[2], o2[2];
#pragma unroll
            for (int n = 0; n < 2; ++n)
#pragma unroll
                for (int e = 0; e < 4; ++e) {
                    const float ang = pos * __builtin_amdgcn_exp2f(-(float)(j0 + 4 * n + e) * (13.287712379549449f / 63.0f));
                    const float nr = __builtin_rintf(ang * 0.15915493667125702f);
                    const float rev = __builtin_fmaf(ang, 0.15915493667125702f, -nr) + ang * 6.4206382432985265e-09f;
                    const float sn = __builtin_amdgcn_sinf(rev), cs = __builtin_amdgcn_cosf(rev);
                    const float x1 = v[0][n][e] * ksc, x2 = v[1][n][e] * ksc;
                    o1[n][e] = x1 * cs - x2 * sn; o2[n][e] = x1 * sn + x2 * cs;
                }
            bf16_t* rp = (seg == 0 ? RQ : RK) + (size_t)row * 1024 + head * 128 + j0;
            *(u32x4*)(rp) = pk8(o1[0], o1[1]); *(u32x4*)(rp + 64) = pk8(o2[0], o2[1]);
        } else {
            const bool isg = pn >= 16;
            bf16_t* rp = (isg ? RG : RV) + (size_t)row * 2048 + 256 * ((pn - 8) & 7) + wc * 32 + 8 * fq;
#pragma unroll
            for (int bj = 0; bj < 2; ++bj) { f32x4 a = v[bj][0] * rs, b = v[bj][1] * rs;
                if (isg) {
#pragma unroll
                    for (int e = 0; e < 4; ++e) { a[e] = a[e] * sigmoidf_fast(a[e]); b[e] = b[e] * sigmoidf_fast(b[e]); } }
                *(u32x4*)(rp + bj * HALF) = pk8(a, b); }
        }
    }
};
struct NoHook { __device__ __forceinline__ void operator()(int) const {} };
template <class Epi, class Sched, bool ALIGN_EPI = false, bool SP2 = false, int KC = 0, bool PKA = false, bool PKB = false, class Hook = NoHook>
__device__ __forceinline__ void gemm_phase(PG8_LAS unsigned char* lds, const Gemm g, const Sched& S, const Epi& E, const Hook& H = Hook()) {
    int tid_ = threadIdx.x; asm volatile("" : "+v"(tid_));
    const int tid = tid_, wid = __builtin_amdgcn_readfirstlane(tid >> 6), lane = tid & 63, wr = wid >> 2, wc = wid & 3, fr = lane & 15, fq = lane >> 4;
    const int K = KC ? KC : g.K, nt = K / BK;
    unsigned voffA[2], voffB[2];
#pragma unroll
    for (int i = 0; i < 2; ++i) { int R, C; stage_rc(tid * 16 + i * 8192, R, C); const int Rb = Epi::PERM ? ((R & ~31) + perm32(R & 31)) : R;
        voffA[i] = PKA ? (unsigned)(tid * 16 + i * 8192) : (unsigned)(R * K + C) * 2u; voffB[i] = PKB ? (unsigned)(tid * 16 + i * 8192) : (unsigned)(Rb * K + C) * 2u; }
    const size_t kstepA = PKA ? (size_t)(2 * HTB) : (size_t)(BK * 2), kstepB = PKB ? (size_t)(2 * HTB) : (size_t)(BK * 2);
    const size_t hstepA = PKA ? (size_t)HTB : (size_t)HALF * K * 2, hstepB = PKB ? (size_t)HTB : (size_t)HALF * K * 2;
    const size_t tstepA = PKA ? (size_t)nt * 2 * HTB : (size_t)BM * K * 2, tstepB = PKB ? (size_t)nt * 2 * HTB : (size_t)BM * K * 2;
    const unsigned ldsw = (unsigned)wid * 1024u;
    const int aoff = lds_byte(wr * 64 + fr, fq * 8), boff = lds_byte(wc * 32 + fr, fq * 8);
#define PG8_SA(b, h) (((b) * 2 + (h)) * HTB)
#define PG8_SB(b, h) ((4 + (b) * 2 + (h)) * HTB)
#define PG8_STAGE(bufoff, gbase, voff) do { _Pragma("unroll") for (int _i = 0; _i < 2; ++_i) \
        __builtin_amdgcn_global_load_lds((const unsigned*)((const char*)(gbase) + (voff)[_i]), (PG8_LAS unsigned*)(lds + (bufoff) + ldsw + _i * 8192), 16, 0, 0); } while (0)
#define PG8_LDA(dst, b, h) do { _Pragma("unroll") for (int m = 0; m < 4; ++m) _Pragma("unroll") for (int k = 0; k < 2; ++k) dst[m][k] = *(const PG8_LAS bf16x8*)(lds + PG8_SA(b, h) + aoff + m * 2048 + k * 1024); } while (0)
#define PG8_LDB(dst, b, h) do { _Pragma("unroll") for (int n = 0; n < 2; ++n) _Pragma("unroll") for (int k = 0; k < 2; ++k) dst[n][k] = *(const PG8_LAS bf16x8*)(lds + PG8_SB(b, h) + boff + n * 2048 + k * 1024); } while (0)
#define PG8_MMA(ai, bj, At, Bt) do { __builtin_amdgcn_s_setprio(1); _Pragma("unroll") for (int m = 0; m < 4; ++m) _Pragma("unroll") for (int n = 0; n < 2; ++n) _Pragma("unroll") for (int k = 0; k < 2; ++k) \
        acc[ai][bj][m][n] = __builtin_amdgcn_mfma_f32_16x16x32_bf16(Bt[n][k], At[m][k], acc[ai][bj][m][n], 0, 0, 0); __builtin_amdgcn_s_setprio(0); } while (0)
#define PG8_WAIT_V(n) asm volatile("s_waitcnt vmcnt(" #n ")" ::: "memory")
#define PG8_WAIT_L(n) asm volatile("s_waitcnt lgkmcnt(" #n ")" ::: "memory")
#define PG8_BAR __builtin_amdgcn_s_barrier()
#define PG8_SCHED __builtin_amdgcn_sched_barrier(0)
    Unit cur, nxt; int ui = 0;
    if (!S.next(0, cur)) return;
    f32x4 acc[2][2][4][2];
    if constexpr (Epi::INIT) E.init(acc, cur, wr, wc, fr, fq);
    else {
#pragma unroll
    for (int a = 0; a < 2; ++a)
#pragma unroll
        for (int b = 0; b < 2; ++b)
#pragma unroll
            for (int m = 0; m < 4; ++m)
#pragma unroll
                for (int n = 0; n < 2; ++n) acc[a][b][m][n] = (f32x4){0.f, 0.f, 0.f, 0.f};
    }
    bf16x8 At[4][2], B0[2][2], B1[2][2];
    const char* cA = (const char*)g.A + (size_t)cur.pm * tstepA; const char* cB = (const char*)g.Bt + (size_t)cur.pn * tstepB;
    S.a_ready(cur);
    if constexpr (SP2) {
        PG8_STAGE(PG8_SB(0, 0), cB, voffB); PG8_STAGE(PG8_SB(0, 1), cB + hstepB, voffB); PG8_STAGE(PG8_SA(0, 0), cA, voffA); PG8_STAGE(PG8_SA(0, 1), cA + hstepA, voffA);
        H(tid);
        if (wr == 1) PG8_BAR;
        PG8_WAIT_V(2); PG8_BAR;
        PG8_STAGE(PG8_SB(1, 0), cB + kstepB, voffB); PG8_STAGE(PG8_SA(1, 0), cA + kstepA, voffA); PG8_STAGE(PG8_SB(1, 1), cB + hstepB + kstepB, voffB);
        PG8_WAIT_V(6); PG8_BAR;
    } else {
        PG8_STAGE(PG8_SB(0, 0), cB, voffB); PG8_STAGE(PG8_SA(0, 0), cA, voffA); PG8_STAGE(PG8_SB(0, 1), cB + hstepB, voffB); PG8_STAGE(PG8_SA(0, 1), cA + hstepA, voffA);
        if (wr == 1) PG8_BAR;
        PG8_WAIT_V(4); PG8_BAR;
        PG8_STAGE(PG8_SB(1, 0), cB + kstepB, voffB); PG8_STAGE(PG8_SA(1, 0), cA + kstepA, voffA); PG8_STAGE(PG8_SB(1, 1), cB + hstepB + kstepB, voffB);
        PG8_WAIT_V(6); PG8_BAR;
    }
    for (;;) {
        const bool has_next = S.next(ui + 1, nxt);
        const char* nA = has_next ? (const char*)g.A + (size_t)nxt.pm * tstepA : cA; const char* nB = has_next ? (const char*)g.Bt + (size_t)nxt.pn * tstepB : cB;
        for (int t = 0; t < nt; t += 2) {
            const bool last = (t == nt - 2);
            const char* a1 = cA + (size_t)(t + 1) * kstepA;
            const char* a2 = last ? nA : cA + (size_t)(t + 2) * kstepA; const char* b2 = last ? nB : cB + (size_t)(t + 2) * kstepB;
            const char* a3 = a2 + kstepA; const char* b3 = b2 + kstepB;
            if (last && has_next) S.a_ready(nxt);
            if constexpr (SP2) {
            PG8_LDB(B0, 0, 0); PG8_LDB(B1, 0, 1); PG8_SCHED; PG8_LDA(At, 0, 0); PG8_STAGE(PG8_SA(1, 1), a1 + hstepA, voffA);
            PG8_WAIT_V(8); PG8_WAIT_L(0); PG8_BAR; PG8_MMA(0, 0, At, B0); PG8_MMA(0, 1, At, B1); PG8_BAR; PG8_SCHED;
            PG8_LDA(At, 0, 1); PG8_STAGE(PG8_SB(0, 0), b2, voffB); PG8_STAGE(PG8_SB(0, 1), b2 + hstepB, voffB); PG8_STAGE(PG8_SA(0, 0), a2, voffA);
            PG8_WAIT_V(8); PG8_WAIT_L(0); PG8_BAR; PG8_MMA(1, 0, At, B0); PG8_MMA(1, 1, At, B1); PG8_BAR; PG8_SCHED;
            PG8_LDB(B0, 1, 0); PG8_LDB(B1, 1, 1); PG8_SCHED; PG8_LDA(At, 1, 0); PG8_STAGE(PG8_SA(0, 1), a2 + hstepA, voffA);
            PG8_WAIT_V(8); PG8_WAIT_L(0); PG8_BAR; PG8_MMA(0, 0, At, B0); PG8_MMA(0, 1, At, B1); PG8_BAR; PG8_SCHED;
            PG8_LDA(At, 1, 1); PG8_STAGE(PG8_SB(1, 0), b3, voffB); PG8_STAGE(PG8_SB(1, 1), b3 + hstepB, voffB); PG8_STAGE(PG8_SA(1, 0), a3, voffA);
            PG8_WAIT_V(8); PG8_WAIT_L(0); PG8_BAR; PG8_MMA(1, 0, At, B0); PG8_MMA(1, 1, At, B1); PG8_BAR; PG8_SCHED;
            } else {
            PG8_LDB(B0, 0, 0); PG8_SCHED; PG8_LDA(At, 0, 0); PG8_STAGE(PG8_SA(1, 1), a1 + hstepA, voffA);
            PG8_WAIT_L(8); PG8_BAR; PG8_WAIT_L(0); PG8_MMA(0, 0, At, B0); PG8_BAR; PG8_SCHED;
            PG8_LDB(B1, 0, 1); PG8_STAGE(PG8_SB(0, 0), b2, voffB);
            PG8_BAR; PG8_WAIT_L(0); PG8_MMA(0, 1, At, B1); PG8_BAR;
            PG8_LDA(At, 0, 1); PG8_STAGE(PG8_SA(0, 0), a2, voffA);
            PG8_BAR; PG8_WAIT_L(0); PG8_MMA(1, 0, At, B0); PG8_BAR; PG8_SCHED;
            PG8_STAGE(PG8_SB(0, 1), b2 + hstepB, voffB);
            PG8_WAIT_V(6); PG8_BAR; PG8_MMA(1, 1, At, B1); PG8_BAR;
            PG8_LDB(B0, 1, 0); PG8_SCHED; PG8_LDA(At, 1, 0); PG8_STAGE(PG8_SA(0, 1), a2 + hstepA, voffA);
            PG8_WAIT_L(8); PG8_BAR; PG8_WAIT_L(0); PG8_MMA(0, 0, At, B0); PG8_BAR; PG8_SCHED;
            PG8_LDB(B1, 1, 1); PG8_STAGE(PG8_SB(1, 0), b3, voffB);
            PG8_BAR; PG8_WAIT_L(0); PG8_MMA(0, 1, At, B1); PG8_BAR;
            PG8_LDA(At, 1, 1); PG8_STAGE(PG8_SA(1, 0), a3, voffA);
            PG8_BAR; PG8_WAIT_L(0); PG8_MMA(1, 0, At, B0); PG8_BAR; PG8_SCHED;
            PG8_STAGE(PG8_SB(1, 1), b3 + hstepB, voffB);
            PG8_WAIT_V(6); PG8_BAR; PG8_MMA(1, 1, At, B1); PG8_BAR;
            }
        }
        if constexpr (ALIGN_EPI) { if (wr == 0) PG8_BAR; }
        if constexpr (!Epi::AFTER_DRAIN) { E(acc, cur, wr, wc, fr, fq); S.done(cur); }
#ifdef EPI_REP
        if constexpr (Epi::IDEMP) { for (int q_ = 1; q_ < EPI_REP; ++q_) {
            _Pragma("unroll") for (int a = 0; a < 2; ++a) _Pragma("unroll") for (int b = 0; b < 2; ++b) _Pragma("unroll") for (int m = 0; m < 4; ++m) _Pragma("unroll") for (int n = 0; n < 2; ++n) asm volatile("" : "+v"(acc[a][b][m][n]));
            E(acc, cur, wr, wc, fr, fq); } }
#endif
        if (!has_next) break;
        if constexpr (Epi::INIT) E.init(acc, nxt, wr, wc, fr, fq);
        else {
#pragma unroll
        for (int a = 0; a < 2; ++a)
#pragma unroll
            for (int b = 0; b < 2; ++b)
#pragma unroll
                for (int m = 0; m < 4; ++m)
#pragma unroll
                    for (int n = 0; n < 2; ++n) acc[a][b][m][n] = (f32x4){0.f, 0.f, 0.f, 0.f};
        }
        cur = nxt; cA = nA; cB = nB; ++ui;
        if constexpr (ALIGN_EPI) { if (wr == 1) PG8_BAR; }
    }
    PG8_WAIT_V(0);
    if constexpr (!ALIGN_EPI) { if (wr == 0) PG8_BAR; }
    PG8_BAR;
    if constexpr (Epi::AFTER_DRAIN) { E.fused(acc, cur, wr, wc, fr, fq, lds, wid, lane); S.done(cur); }
#undef PG8_SA
#undef PG8_SB
#undef PG8_STAGE
#undef PG8_LDA
#undef PG8_LDB
#undef PG8_MMA
#undef PG8_WAIT_V
#undef PG8_WAIT_L
#undef PG8_BAR
#undef PG8_SCHED
}
}
namespace pg8 {
template <class Epi>
__device__ __forceinline__ void sample_wide_unit(PG8_LAS unsigned char* lds, PG8_LAS float* rsl, const bf16_t* Ximg, const bf16_t* Bimg, const float* SSQS, int unit  , const Epi& E) {
    int tid_ = threadIdx.x; asm volatile("" : "+v"(tid_));
    const int tid = tid_, wid = __builtin_amdgcn_readfirstlane(tid >> 6), lane = tid & 63, wc = wid & 3, kh = wid >> 2, fr = lane & 15, fq = lane >> 4;
    const int rb = unit & 7, pn = unit >> 3;
    const int pm = EP_MP / BM + (rb >> 2), ai = (rb >> 1) & 1, wr = rb & 1;
    constexpr int NT = 16;
    { const char* asrc = (const char*)Ximg + ((size_t)pm * NT * 2 + ai) * HTB + wr * 8192 + tid * 16; asm volatile("" : "+v"(asrc));
#pragma unroll
      for (int kt = 0; kt < NT; ++kt) __builtin_amdgcn_global_load_lds((const unsigned*)(asrc + (size_t)kt * 2 * HTB), (PG8_LAS unsigned*)(lds + kt * 8192 + wid * 1024), 16, 0, 0); }
    { const int r = tid >> 3, part = tid & 7; const float* q = SSQS + (size_t)(rb * 64 + r) * 64 + 8 * part;
      const f32x4 a = *(const f32x4*)q, b = *(const f32x4*)(q + 4);
      float s = ((a[0] + a[1]) + (a[2] + a[3])) + ((b[0] + b[1]) + (b[2] + b[3]));
      s += __int_as_float(__builtin_amdgcn_ds_bpermute((lane ^ 1) << 2, __float_as_int(s))); s += __int_as_float(__builtin_amdgcn_ds_bpermute((lane ^ 2) << 2, __float_as_int(s)));
      s += __int_as_float(__builtin_amdgcn_ds_bpermute((lane ^ 4) << 2, __float_as_int(s)));
      if (part == 0) rsl[r] = __builtin_amdgcn_rsqf(s * (1.0f / 1024.0f) + 1e-6f); }
    const unsigned laneoff = (unsigned)((fr * 64 + fq * 16) ^ ((fr >> 3) << 5));
    const char* bsrc = (const char*)Bimg + (size_t)pn * NT * 2 * HTB + (size_t)(8 * kh) * 2 * HTB + wc * 4096 + laneoff; asm volatile("" : "+v"(bsrc));
    constexpr int NST = 4;
    bf16x8 bq[NST][2][2][2];
#define SW_LOADB(st, i) do { _Pragma("unroll") for (int bj = 0; bj < 2; ++bj) _Pragma("unroll") for (int n = 0; n < 2; ++n) _Pragma("unroll") for (int k2 = 0; k2 < 2; ++k2) \
        bq[st][bj][n][k2] = *(const bf16x8*)(bsrc + (size_t)((i) * 2 + bj) * HTB + (n * 2 + k2) * 1024); } while (0)
    SW_LOADB(0, 0); SW_LOADB(1, 1); SW_LOADB(2, 2); SW_LOADB(3, 3);
    asm volatile("s_waitcnt vmcnt(32)" ::: "memory");
    __syncthreads();
    f32x4 acc[2][4][2];
#pragma unroll
    for (int bj = 0; bj < 2; ++bj)
#pragma unroll
        for (int m = 0; m < 4; ++m)
#pragma unroll
            for (int n = 0; n < 2; ++n) acc[bj][m][n] = (f32x4){0.f, 0.f, 0.f, 0.f};
#pragma unroll
    for (int i = 0; i < 8; ++i) {
        bf16x8 a[4][2];
#pragma unroll
        for (int m = 0; m < 4; ++m)
#pragma unroll
            for (int k2 = 0; k2 < 2; ++k2) a[m][k2] = *(const PG8_LAS bf16x8*)(lds + (8 * kh + i) * 8192 + (2 * m + k2) * 1024 + laneoff);
#pragma unroll
        for (int k2 = 0; k2 < 2; ++k2)
#pragma unroll
            for (int bj = 0; bj < 2; ++bj)
#pragma unroll
                for (int m = 0; m < 4; ++m)
#pragma unroll
                    for (int n = 0; n < 2; ++n) acc[bj][m][n] = __builtin_amdgcn_mfma_f32_16x16x32_bf16(bq[i % NST][bj][n][k2], a[m][k2], acc[bj][m][n], 0, 0, 0);
        if (i + NST < 8) SW_LOADB(i % NST, i + NST);
    }
#undef SW_LOADB
    __syncthreads();
    PG8_LAS f32x4* xch = (PG8_LAS f32x4*)lds;
    f32x4 fin[2][2][2];
    if (kh == 0) {
#pragma unroll
        for (int bj = 0; bj < 2; ++bj)
#pragma unroll
            for (int m2 = 0; m2 < 2; ++m2)
#pragma unroll
                for (int n = 0; n < 2; ++n) xch[(((wid * 2 + bj) * 2 + m2) * 2 + n) * 64 + lane] = acc[bj][2 + m2][n];
    } else {
#pragma unroll
        for (int bj = 0; bj < 2; ++bj)
#pragma unroll
            for (int m2 = 0; m2 < 2; ++m2)
#pragma unroll
                for (int n = 0; n < 2; ++n) xch[(((wid * 2 + bj) * 2 + m2) * 2 + n) * 64 + lane] = acc[bj][m2][n];
    }
    __syncthreads();
    { const int pw = wid ^ 4;
      if (kh == 0) {
#pragma unroll
        for (int bj = 0; bj < 2; ++bj)
#pragma unroll
            for (int m2 = 0; m2 < 2; ++m2)
#pragma unroll
                for (int n = 0; n < 2; ++n) fin[bj][m2][n] = acc[bj][m2][n] + xch[(((pw * 2 + bj) * 2 + m2) * 2 + n) * 64 + lane];
      } else {
#pragma unroll
        for (int bj = 0; bj < 2; ++bj)
#pragma unroll
            for (int m2 = 0; m2 < 2; ++m2)
#pragma unroll
                for (int n = 0; n < 2; ++n) fin[bj][m2][n] = acc[bj][2 + m2][n] + xch[(((pw * 2 + bj) * 2 + m2) * 2 + n) * 64 + lane];
      } }
#pragma unroll
    for (int m2 = 0; m2 < 2; ++m2) {
        const int rl = (2 * kh + m2) * 16 + fr;
        const f32x4 v[2][2] = {{fin[0][m2][0], fin[0][m2][1]}, {fin[1][m2][0], fin[1][m2][1]}};
        E.rowgrp(v, EP_MP + rb * 64 + rl, rsl[rl], pn, wc, fr, fq);
    }
    __syncthreads();
}
}
#include <hip/hip_bf16.h>
#include <cmath>
namespace attn_body {
using bf16=__hip_bfloat16;
using bf16x8=__attribute__((ext_vector_type(8)))short;
using s16x4=__attribute__((ext_vector_type(4)))short;
using f32x16=__attribute__((ext_vector_type(16)))float;
using u32x4=__attribute__((ext_vector_type(4)))unsigned;
constexpr int BATCH=2,NHEAD=16,SEQ=16384,D=64,DM=NHEAD*D;
constexpr int NW=8,QBLK=32,QB=QBLK*NW,KVBLK=64,NQB=SEQ/QB;
constexpr int ATTN_PITCH=DM, ATTN_UNIT_ROWS=QB;
__device__ __forceinline__ int crow(int r,int hi){return (r&3)+8*(r>>2)+4*hi;}
#define SBAR() __builtin_amdgcn_sched_barrier(0)
__device__ __forceinline__ void cmask(f32x16&p0,f32x16&p1,int jb,int qrel,int hi){
  const float NEG=-INFINITY; int kb=64*jb+4*hi;
  #pragma unroll
  for(int r=0;r<16;++r){int kv=kb+(r&3)+8*(r>>2); if(kv>qrel)p0[r]=NEG; if(kv+32>qrel)p1[r]=NEG;}
}

constexpr int NSLOT=3, SLOTB=8192;
constexpr int LDS_K=0, LDS_V=NSLOT*SLOTB, LDS_WS=2*NSLOT*SLOTB, LDS_OST=LDS_WS+NW*64*4, LDS_CB=LDS_OST+NW*4096, LDS_GS=LDS_CB+NW*768, LDS_BYTES=LDS_GS+NW*4096;
constexpr float C2=0.125f*1.4426950408889634f;
__device__ __forceinline__ void glds16(const void*gsrc,unsigned lds_dst){unsigned keep;
  asm volatile("s_mov_b32 %0, m0\n\ts_mov_b32 m0, %2\n\ts_nop 0\n\tglobal_load_lds_dwordx4 %1, off\n\ts_mov_b32 m0, %0":"=&s"(keep):"v"(gsrc),"s"(lds_dst):"memory");}
__device__ __forceinline__ void glds16s(const void*sbase,unsigned voff,unsigned lds_dst){unsigned keep;
  asm volatile("s_nop 4\n\ts_mov_b32 %0, m0\n\ts_mov_b32 m0, %3\n\ts_nop 0\n\tglobal_load_lds_dwordx4 %1, %2\n\ts_mov_b32 m0, %0":"=&s"(keep):"v"(voff),"s"(sbase),"s"(lds_dst):"memory");}
__device__ __forceinline__ void glds4s(const void*sbase,unsigned voff,unsigned lds_dst){unsigned keep;
  asm volatile("s_nop 4\n\ts_mov_b32 %0, m0\n\ts_mov_b32 m0, %3\n\ts_nop 0\n\tglobal_load_lds_dword %1, %2\n\ts_mov_b32 m0, %0":"=&s"(keep):"v"(voff),"s"(sbase),"s"(lds_dst):"memory");}
__device__ __forceinline__ float max3f(float a,float b,float c){float r;asm("v_max3_f32 %0, %1, %2, %3":"=v"(r):"v"(a),"v"(b),"v"(c));return r;}
__device__ __forceinline__ float max2f(float a,float b){float r;asm("v_max_f32_e32 %0, %1, %2":"=v"(r):"v"(a),"v"(b));return r;}
__device__ __forceinline__ float fadd_s(float a,float b){float r;asm("v_add_f32_e32 %0, %1, %2":"=v"(r):"v"(a),"v"(b));return r;}
__device__ __forceinline__ float fsub_s(float a,float b){float r;asm("v_sub_f32_e32 %0, %1, %2":"=v"(r):"v"(a),"v"(b));return r;}
typedef float f32x4_t __attribute__((ext_vector_type(4))); typedef float f32x2_t __attribute__((ext_vector_type(2))); typedef __bf16 bf16x2_t __attribute__((ext_vector_type(2)));
__device__ __forceinline__ unsigned cvtpk_s(float lo,float hi){f32x2_t v={lo,hi};bf16x2_t b=__builtin_convertvector(v,bf16x2_t);return __builtin_bit_cast(unsigned,b);}
#define WAIT_BAR(N) asm volatile("s_waitcnt vmcnt(" #N ") lgkmcnt(0)\n\ts_barrier":::"memory")

__device__ __forceinline__ void qkt(f32x16&p0,f32x16&p1,const char*Kslot,const bf16x8*qr,const f32x16&negm,int r32,int hi){
  const char*kb=Kslot+hi*1024+r32*16;
  #pragma unroll
  for(int d0=0;d0<4;++d0){
    const bf16x8 b0=*reinterpret_cast<const bf16x8*>(kb+d0*2048);
    const bf16x8 b1=*reinterpret_cast<const bf16x8*>(kb+d0*2048+512);
    if(d0==0){p0=__builtin_amdgcn_mfma_f32_32x32x16_bf16(b0,qr[0],negm,0,0,0);p1=__builtin_amdgcn_mfma_f32_32x32x16_bf16(b1,qr[0],negm,0,0,0);}
    else{p0=__builtin_amdgcn_mfma_f32_32x32x16_bf16(b0,qr[d0],p0,0,0,0);p1=__builtin_amdgcn_mfma_f32_32x32x16_bf16(b1,qr[d0],p1,0,0,0);}}
}
typedef __attribute__((address_space(3))) const char* lds_cptr;
typedef short v4i16_t __attribute__((ext_vector_type(4)));
__device__ __forceinline__ void kload8(bf16x8*kf,lds_cptr kp){
  kf[0]=*(const __attribute__((address_space(3))) bf16x8*)(kp);      kf[1]=*(const __attribute__((address_space(3))) bf16x8*)(kp+512);
  kf[2]=*(const __attribute__((address_space(3))) bf16x8*)(kp+2048); kf[3]=*(const __attribute__((address_space(3))) bf16x8*)(kp+2560);
  kf[4]=*(const __attribute__((address_space(3))) bf16x8*)(kp+4096); kf[5]=*(const __attribute__((address_space(3))) bf16x8*)(kp+4608);
  kf[6]=*(const __attribute__((address_space(3))) bf16x8*)(kp+6144); kf[7]=*(const __attribute__((address_space(3))) bf16x8*)(kp+6656);
}
__device__ __forceinline__ void kload2(bf16x8*kf,lds_cptr kp,int j){ kf[2*j]=*(const __attribute__((address_space(3))) bf16x8*)(kp+j*2048); kf[2*j+1]=*(const __attribute__((address_space(3))) bf16x8*)(kp+j*2048+512); }
__device__ __forceinline__ s16x4 vtr(lds_cptr p){ return __builtin_bit_cast(s16x4,__builtin_amdgcn_ds_read_tr16_b64_v4i16((__attribute__((address_space(3))) v4i16_t*)p)); }
__device__ __forceinline__ float rowmax(const f32x16&p0,const f32x16&p1){
  float a=max3f(p0[0],p0[1],p1[0]),b=max3f(p0[2],p0[3],p1[1]);a=max3f(a,p1[2],p1[3]);
  #pragma unroll
  for(int r=4;r<16;r+=4){a=max3f(a,p0[r],p0[r+1]);b=max3f(b,p0[r+2],p0[r+3]);a=max3f(a,p1[r],p1[r+1]);b=max3f(b,p1[r+2],p1[r+3]);}
  const float m=max2f(a,b);
  auto rr=__builtin_amdgcn_permlane32_swap(__float_as_uint(m),__float_as_uint(m),false,false);
  return max2f(__uint_as_float(rr[0]),__uint_as_float(rr[1]));
}
__device__ __forceinline__ void pv(f32x16*o,int vb,bf16x8 pa0,bf16x8 pa1,bf16x8 pa2,bf16x8 pa3){
  #pragma unroll
  for(int d0=0;d0<2;++d0){s16x4 lo[4],hi[4];
    #pragma unroll
    for(int ks=0;ks<4;++ks){
      asm volatile("ds_read_b64_tr_b16 %0,%1 offset:%c2":"=&v"(lo[ks]):"v"(vb),"i"(d0*4096+ks*1024):"memory");
      asm volatile("ds_read_b64_tr_b16 %0,%1 offset:%c2":"=&v"(hi[ks]):"v"(vb),"i"(d0*4096+ks*1024+512):"memory");}
    asm volatile("s_waitcnt lgkmcnt(0)":::"memory");SBAR();
    #define PK(k) (bf16x8){lo[k][0],lo[k][1],lo[k][2],lo[k][3],hi[k][0],hi[k][1],hi[k][2],hi[k][3]}
    o[d0]=__builtin_amdgcn_mfma_f32_32x32x16_bf16(pa0,PK(0),o[d0],0,0,0);
    o[d0]=__builtin_amdgcn_mfma_f32_32x32x16_bf16(pa1,PK(1),o[d0],0,0,0);
    o[d0]=__builtin_amdgcn_mfma_f32_32x32x16_bf16(pa2,PK(2),o[d0],0,0,0);
    o[d0]=__builtin_amdgcn_mfma_f32_32x32x16_bf16(pa3,PK(3),o[d0],0,0,0);
    #undef PK
  }
}

#ifndef ATTN_STORE16
#define ATTN_STORE16(p,v) (*(u32x4*)(p)=(v))
#endif
template<int THRL> __device__ __forceinline__ void attn_unit(int b,int h,int qb,int t0,const bf16*Q,const bf16*__restrict__ K,const bf16*__restrict__ V,const bf16*__restrict__ G,const float*__restrict__ ND,bf16*O,char*shm,unsigned nk,volatile __attribute__((address_space(3))) unsigned*nkslot){
  int tid_=threadIdx.x; asm volatile("":"+v"(tid_)); const int tid=tid_,lane=tid&63,r32=lane&31,hi=lane>>5; const int wid=__builtin_amdgcn_readfirstlane(tid>>6);
  const long rowbase=(long)b*SEQ; const int q0=qb*QB;
  const bf16*Qw=Q+(rowbase+q0+wid*QBLK)*DM+h*D;
  const bf16*Kh=K+(rowbase+(long)t0*KVBLK)*DM+h*D,*Vh=V+(rowbase+(long)t0*KVBLK)*DM+h*D;
  const float*NDh=ND+((long)b*NHEAD+h)*SEQ; const float*Ct0=NDh+(long)t0*KVBLK;
  const unsigned lds0=(unsigned)(uintptr_t)shm;
  float*wsf=(float*)(shm+LDS_WS)+wid*64;
  const unsigned koff=(unsigned)(lane*DM)*2u;
  const bf16*Khw=Kh+wid*8,*Vhw=Vh+(16*(wid&3))*DM+(wid>>2)*32;
  const unsigned kdst=lds0+LDS_K+wid*1024, vdst=lds0+LDS_V+wid*1024;
  #define DMA_K(t,slot) glds16s(Khw+(long)(t)*KVBLK*DM,koff,(unsigned)__builtin_amdgcn_readfirstlane(kdst+(slot)))
  #define DMA_V(t,slot) do{ unsigned x_=koff; asm volatile("":"+v"(x_)); glds16s(Vhw+(long)(t)*KVBLK*DM,((x_>>2)&0xFFFFF800u)+((x_>>11)&3u)*16u,(unsigned)__builtin_amdgcn_readfirstlane(vdst+(slot))); }while(0)
  const unsigned cdst=lds0+LDS_CB+wid*768;
  #define DMA_C(t,slot) do{ unsigned x_=koff; asm volatile("":"+v"(x_)); glds4s(Ct0+(long)(t)*KVBLK,x_>>9,(unsigned)__builtin_amdgcn_readfirstlane(cdst+((slot)>>5))); }while(0)
  const lds_cptr cbp0=(lds_cptr)shm+LDS_CB+wid*768+hi*16;
  #define BIAS(P0,P1,slot) do{ const lds_cptr cb_=cbp0+((slot)>>5); _Pragma("unroll") for(int g_=0;g_<4;++g_){ const f32x4_t b0_=*(const __attribute__((address_space(3))) f32x4_t*)(cb_+g_*32), b1_=*(const __attribute__((address_space(3))) f32x4_t*)(cb_+128+g_*32); \
      P0[4*g_]+=b0_[0];P0[4*g_+1]+=b0_[1];P0[4*g_+2]+=b0_[2];P0[4*g_+3]+=b0_[3]; P1[4*g_]+=b1_[0];P1[4*g_+1]+=b1_[1];P1[4*g_+2]+=b1_[2];P1[4*g_+3]+=b1_[3]; } }while(0)
  const int vb0=(int)(lds0+LDS_V)+((lane>>4)&1)*32+(lane&3)*8+(4*hi+((lane&15)>>2))*64;
  const char*Kbase=shm+LDS_K; bf16x8 kf[8];
  const lds_cptr shm3=(lds_cptr)shm; const lds_cptr kp0=shm3+LDS_K+hi*1024+r32*16; const lds_cptr vp0=shm3+LDS_V+((lane>>4)&1)*32+(lane&3)*8+(4*hi+((lane&15)>>2))*64;
  const int NT=(q0+QB)/KVBLK-t0;
  { const bf16*Gw=G+(rowbase+q0+wid*QBLK)*DM+h*D; unsigned x_=koff; asm volatile("":"+v"(x_)); const unsigned goff=((x_>>3)&0xFFFFF800u)+((x_>>11)&7u)*16u, gdst=lds0+LDS_GS+wid*4096;
    #pragma unroll
    for(int i=0;i<4;++i)glds16s(Gw+(long)i*8*DM,goff,(unsigned)__builtin_amdgcn_readfirstlane(gdst+i*1024)); }
  DMA_K(0,0);DMA_C(0,0);DMA_V(0,0);DMA_K(1,SLOTB);
  bf16x8 qr[4];
  #pragma unroll
  for(int d0=0;d0<4;++d0)qr[d0]=*reinterpret_cast<const bf16x8*>(&Qw[(long)r32*DM+d0*16+hi*8]);
  const float ndi=NDh[q0+wid*QBLK+r32];
  float mhat,l_reg=0.f;f32x16 o[2];o[0]=f32x16{};o[1]=f32x16{};f32x16 negm;
  const int qrel=wid*QBLK+r32;
  #define CMASK(P0,P1,t) do{int jb_=(t)-(NT-4); if(jb_>=0)cmask(P0,P1,jb_,qrel,hi);}while(0)
  bool resc=false;
  #define START(P0,P1) do{ const float rm=rowmax(P0,P1); resc=false; \
    { const float dl=max2f(rm,0.f); mhat=fadd_s(mhat,dl); \
      _Pragma("unroll") for(int r=0;r<16;++r){P0[r]=fsub_s(P0[r],dl);P1[r]=fsub_s(P1[r],dl);} \
      _Pragma("unroll") for(int r=0;r<16;++r)negm[r]=-mhat; asm volatile("":"+v"(negm)); } \
    _Pragma("unroll") for(int r=0;r<16;++r)P0[r]=__builtin_amdgcn_exp2f(P0[r]); }while(0)
  #define RESC() do{ if(resc){ asm volatile("s_waitcnt lgkmcnt(0)":::"memory"); \
      _Pragma("unroll") for(int d_=0;d_<2;++d_) _Pragma("unroll") for(int r=0;r<16;++r)o[d_][r]*=wsf[crow(r,hi)]; } }while(0)
  f32x16 pA0,pA1,pB0,pB1;
  int sl_prev=0,sl_cur=0,sl_next=SLOTB;
  #define ROT() do{sl_prev=sl_cur;sl_cur=sl_next;sl_next=(sl_next==(NSLOT-1)*SLOTB)?0:sl_next+SLOTB;}while(0)
  DMA_K(2,2*SLOTB);DMA_C(1,SLOTB);
  WAIT_BAR(3); if(tid==0)*nkslot=nk;
  mhat=ndi; _Pragma("unroll") for(int r=0;r<16;++r)negm[r]=-ndi; asm volatile("":"+v"(negm));
  qkt(pA0,pA1,Kbase,qr,negm,r32,hi);asm volatile("s_nop 15\n\ts_nop 7":"+v"(pA0),"+v"(pA1));BIAS(pA0,pA1,0);CMASK(pA0,pA1,0);
  START(pA0,pA1);
  _Pragma("unroll") for(int r=0;r<16;++r)pA1[r]=__builtin_amdgcn_exp2f(pA1[r]);
  WAIT_BAR(0);
  DMA_K(3,0);DMA_V(1,SLOTB);DMA_C(2,2*SLOTB);
  ROT();
  kload8(kf,kp0+sl_cur);
  WAIT_BAR(3);
  s16x4 vlo[8],vhi[8]; u32x4 pw0,pw1,pw2,pw3;
  #define PKW(P,B) cvtpk_s(P[B],P[B+1])
  #define PAF(k) __builtin_bit_cast(bf16x8,pw##k)
  #define VFR(i) (bf16x8){vlo[i][0],vlo[i][1],vlo[i][2],vlo[i][3],vhi[i][0],vhi[i][1],vhi[i][2],vhi[i][3]}
  #define PIN(x) asm volatile("":"+v"(x))
  #define MX3(a,b,c) __builtin_fmaxf(__builtin_fmaxf((a),(b)),(c))
  #define GAPA(MF,A0,A1,A2,A3,W0,W1,PW) do{ MF; sacc+=A0; sacc+=A1; sacc+=A2; sacc+=A3; PIN(sacc); W0; W1; PIN(PW); SBAR(); }while(0)
  #define EX(v) __builtin_amdgcn_exp2f(v)
  #define GAPB(MF,X,B) do{ MF; X[B]=EX(X[B]); X[B+1]=EX(X[B+1]); X[B+2]=EX(X[B+2]); X[B+3]=EX(X[B+3]); PIN(X); SBAR(); }while(0)
  #define VRD(i) do{ vlo[i]=vtr(vp_+(((i)>>2)*4096+((i)&3)*1024)); vhi[i]=vtr(vp_+(((i)>>2)*4096+((i)&3)*1024+512)); }while(0)
  #define KRD(G,j) do{ if(G){ kload2(kf,kp0+sl_next,j); SBAR(); } }while(0)
  #define STEP(C0,C1,P0,P1,t,GK,GV,GL,GC) do{ SBAR(); \
    const lds_cptr vp_=vp0+sl_prev; \
    VRD(0); SBAR(); float sacc=(P0[0]+P0[1]); \
    GAPA(C0=__builtin_amdgcn_mfma_f32_32x32x16_bf16(kf[0],qr[0],negm,0,0,0), P0[2],P0[3],P0[4],P0[5],     pw0[0]=PKW(P0,0), pw0[1]=PKW(P0,2), pw0); \
    VRD(4); SBAR(); GAPA(C1=__builtin_amdgcn_mfma_f32_32x32x16_bf16(kf[1],qr[0],negm,0,0,0), P0[6],P0[7],P0[8],P0[9],     pw0[2]=PKW(P0,4), pw0[3]=PKW(P0,6), pw0); \
    VRD(1); SBAR(); GAPA(C0=__builtin_amdgcn_mfma_f32_32x32x16_bf16(kf[2],qr[1],C0,0,0,0),   P0[10],P0[11],P0[12],P0[13], pw1[0]=PKW(P0,8), pw1[1]=PKW(P0,10), pw1); \
    VRD(5); SBAR(); GAPA(C1=__builtin_amdgcn_mfma_f32_32x32x16_bf16(kf[3],qr[1],C1,0,0,0),   P0[14],P0[15],P1[0],P1[1],   pw1[2]=PKW(P0,12),pw1[3]=PKW(P0,14), pw1); \
    VRD(2); SBAR(); GAPA(C0=__builtin_amdgcn_mfma_f32_32x32x16_bf16(kf[4],qr[2],C0,0,0,0),   P1[2],P1[3],P1[4],P1[5],     pw2[0]=PKW(P1,0), pw2[1]=PKW(P1,2), pw2); \
    VRD(6); SBAR(); GAPA(C1=__builtin_amdgcn_mfma_f32_32x32x16_bf16(kf[5],qr[2],C1,0,0,0),   P1[6],P1[7],P1[8],P1[9],     pw2[2]=PKW(P1,4), pw2[3]=PKW(P1,6), pw2); \
    VRD(3); SBAR(); GAPA(C0=__builtin_amdgcn_mfma_f32_32x32x16_bf16(kf[6],qr[3],C0,0,0,0),   P1[10],P1[11],P1[12],P1[13], pw3[0]=PKW(P1,8), pw3[1]=PKW(P1,10), pw3); \
    VRD(7); SBAR(); GAPA(C1=__builtin_amdgcn_mfma_f32_32x32x16_bf16(kf[7],qr[3],C1,0,0,0),   P1[14],P1[15],0.f,0.f,       pw3[2]=PKW(P1,12),pw3[3]=PKW(P1,14), pw3); \
    l_reg+=sacc; \
    if(GK){DMA_K((t)+3,sl_cur);} if(GV){DMA_V((t)+1,sl_next);} if(GC){DMA_C((t)+2,sl_prev);} \
    BIAS(C0,C1,sl_cur); CMASK(C0,C1,t); \
    { float a=MX3(C0[0],C0[1],C1[0]),b=MX3(C0[2],C0[3],C1[1]); a=MX3(a,C1[2],C1[3]); \
      _Pragma("unroll") for(int r=4;r<16;r+=4){a=MX3(a,C0[r],C0[r+1]);b=MX3(b,C0[r+2],C0[r+3]);a=MX3(a,C1[r],C1[r+1]);b=MX3(b,C1[r+2],C1[r+3]);} \
      float rm=__builtin_fmaxf(a,b); { auto rr=__builtin_amdgcn_permlane32_swap(__float_as_uint(rm),__float_as_uint(rm),false,false); rm=__builtin_fmaxf(__uint_as_float(rr[0]),__uint_as_float(rr[1])); } \
      resc=false; \
      if(__builtin_expect(__any(rm>(float)THRL),0)){ const float dl=__builtin_fmaxf(rm,0.f); mhat+=dl; \
        _Pragma("unroll") for(int r=0;r<16;++r){C0[r]-=dl;C1[r]-=dl;} \
        _Pragma("unroll") for(int r=0;r<16;++r)negm[r]=-mhat; asm volatile("":"+v"(negm)); \
        const float f=__builtin_amdgcn_exp2f(-dl); l_reg*=f; if(hi==0)wsf[r32]=f; resc=true; } } \
    SBAR(); \
    GAPB(o[0]=__builtin_amdgcn_mfma_f32_32x32x16_bf16(PAF(0),VFR(0),o[0],0,0,0), C0,0); \
    GAPB(o[1]=__builtin_amdgcn_mfma_f32_32x32x16_bf16(PAF(0),VFR(4),o[1],0,0,0), C0,4); \
    KRD(GL,0); GAPB(o[0]=__builtin_amdgcn_mfma_f32_32x32x16_bf16(PAF(1),VFR(1),o[0],0,0,0), C0,8); \
    KRD(GL,1); GAPB(o[1]=__builtin_amdgcn_mfma_f32_32x32x16_bf16(PAF(1),VFR(5),o[1],0,0,0), C0,12); \
    KRD(GL,2); GAPB(o[0]=__builtin_amdgcn_mfma_f32_32x32x16_bf16(PAF(2),VFR(2),o[0],0,0,0), C1,0); \
    KRD(GL,3); GAPB(o[1]=__builtin_amdgcn_mfma_f32_32x32x16_bf16(PAF(2),VFR(6),o[1],0,0,0), C1,4); \
    GAPB(o[0]=__builtin_amdgcn_mfma_f32_32x32x16_bf16(PAF(3),VFR(3),o[0],0,0,0), C1,8); \
    GAPB(o[1]=__builtin_amdgcn_mfma_f32_32x32x16_bf16(PAF(3),VFR(7),o[1],0,0,0), C1,12); \
    }while(0)
  int t=1;
  #undef CMASK
  #define CMASK(P0,P1,t) do{}while(0)
  for(;t+5<NT;t+=2){
    STEP(pB0,pB1,pA0,pA1,t,true,true,true,true);     WAIT_BAR(3); RESC(); ROT();
    STEP(pA0,pA1,pB0,pB1,t+1,true,true,true,true);   WAIT_BAR(3); RESC(); ROT();
  }
  #undef CMASK
  #define CMASK(P0,P1,t) do{int jb_=(t)-(NT-4); if(jb_>=0)cmask(P0,P1,jb_,qrel,hi);}while(0)
  #define ENDW(tt) do{ if((tt)+3<NT){WAIT_BAR(3);} else if((tt)+2<NT){WAIT_BAR(2);} else {WAIT_BAR(0);} }while(0)
  for(;t+1<NT;t+=2){
    STEP(pB0,pB1,pA0,pA1,t,(t+3<NT),(t+1<NT),(t+1<NT),(t+2<NT));       ENDW(t);   RESC(); ROT();
    STEP(pA0,pA1,pB0,pB1,t+1,(t+4<NT),(t+2<NT),(t+2<NT),(t+3<NT));     ENDW(t+1); RESC(); ROT();
  }
  STEP(pB0,pB1,pA0,pA1,NT-1,false,false,false,false); RESC();
  { float sacc=pB0[0]+pB0[1]; _Pragma("unroll") for(int r=2;r<16;++r)sacc+=pB0[r]; _Pragma("unroll") for(int r=0;r<16;++r)sacc+=pB1[r]; l_reg+=sacc;
    pw0=(u32x4){PKW(pB0,0),PKW(pB0,2),PKW(pB0,4),PKW(pB0,6)};pw1=(u32x4){PKW(pB0,8),PKW(pB0,10),PKW(pB0,12),PKW(pB0,14)};pw2=(u32x4){PKW(pB1,0),PKW(pB1,2),PKW(pB1,4),PKW(pB1,6)};pw3=(u32x4){PKW(pB1,8),PKW(pB1,10),PKW(pB1,12),PKW(pB1,14)};
    SBAR(); pv(o,vb0+sl_cur,PAF(0),PAF(1),PAF(2),PAF(3)); }
  #undef PKW
  #undef PAF
  #undef VFR
  #undef PIN
  #undef MX3
  #undef GAPA
  #undef GAPB
  #undef EX
  #undef VRD
  #undef KRD
  #undef STEP
  #undef ENDW
  {auto rr=__builtin_amdgcn_permlane32_swap(__float_as_uint(l_reg),__float_as_uint(l_reg),false,false);l_reg=__uint_as_float(rr[0])+__uint_as_float(rr[1]);}
  if(hi==0)wsf[32+r32]=l_reg;asm volatile("s_waitcnt lgkmcnt(0)":::"memory");
  float rli[16];
  #pragma unroll
  for(int r=0;r<16;++r)rli[r]=__builtin_amdgcn_rcpf(wsf[32+crow(r,hi)]);
  bf16*Ow=O+(rowbase+q0+wid*QBLK)*DM+h*D;
  { bf16*stg=(bf16*)(shm+LDS_OST)+wid*2048;
    #pragma unroll
    for(int r=0;r<16;++r){const int orow=crow(r,hi);
      #pragma unroll
      for(int d0=0;d0<2;++d0)stg[orow*64+d0*32+r32]=__float2bfloat16(o[d0][r]*rli[r]);}
    asm volatile("s_waitcnt lgkmcnt(0)":::"memory");
    #pragma unroll
    for(int i=0;i<4;++i){const int row=i*8+(lane>>3),ch=lane&7; const u32x4 v=*(const u32x4*)(stg+row*64+ch*8); const u32x4 g=*(const __attribute__((address_space(3))) u32x4*)(shm3+LDS_GS+wid*4096+i*1024+lane*16); u32x4 w;
      #pragma unroll
      for(int e=0;e<4;++e){ const float a0=__uint_as_float(v[e]<<16)*__uint_as_float(g[e]<<16), a1=__uint_as_float(v[e]&0xffff0000u)*__uint_as_float(g[e]&0xffff0000u); w[e]=cvtpk_s(a0,a1); }
      ATTN_STORE16(Ow+(long)row*DM+ch*8,w);} }
  asm volatile("s_waitcnt lgkmcnt(0)\n\ts_barrier":::"memory");
  #undef DMA_K
  #undef DMA_V
  #undef DMA_C
  #undef BIAS
  #undef CMASK
  #undef START
  #undef RESC
  #undef ROT
}
constexpr int ATTN_LDS_BYTES=LDS_BYTES;
#undef SBAR
#undef WAIT_BAR
}
#define GAS __attribute__((address_space(1)))
#define LAS __attribute__((address_space(3)))
typedef unsigned short bf16;
typedef unsigned v4u __attribute__((ext_vector_type(4)));
typedef float f32x4 __attribute__((ext_vector_type(4)));
typedef short bf16x8 __attribute__((ext_vector_type(8)));
typedef GAS unsigned gu32;
typedef GAS unsigned long long gu64;
#define RLX_AGENT __ATOMIC_RELAXED, __HIP_MEMORY_SCOPE_AGENT
#define LDS_WAIT() asm volatile("s_waitcnt lgkmcnt(0)" ::: "memory")
#define VM_WAIT() asm volatile("s_waitcnt vmcnt(0)" ::: "memory")
__device__ __forceinline__ unsigned long long rt() { return __builtin_amdgcn_s_memrealtime(); }
__device__ __forceinline__ unsigned f2bf(float f) { unsigned u = __builtin_bit_cast(unsigned, f); return (u + 0x7fffu + ((u >> 16) & 1u)) >> 16; }
__device__ __forceinline__ unsigned pk2(float lo, float hi) { return f2bf(lo) | (f2bf(hi) << 16); }
__device__ __forceinline__ float bperm(float v, int srclane) { return __int_as_float(__builtin_amdgcn_ds_bpermute(srclane << 2, __float_as_int(v))); }
typedef unsigned u32x4q __attribute__((ext_vector_type(4)));
typedef short v4i16q __attribute__((ext_vector_type(4)));
__device__ __forceinline__ unsigned pkq(float lo, float hi) { typedef float f2_ __attribute__((ext_vector_type(2))); typedef __bf16 b2_ __attribute__((ext_vector_type(2))); f2_ v = {lo, hi}; b2_ b = __builtin_convertvector(v, b2_); return __builtin_bit_cast(unsigned, b); }
#define XB_TMO      128
#define XB_XCNT(j)  (256  + 64 * (j))
#define XB_XSUB(j)  (1280 + 64 * (j))
#define XB_XGEN(j)  (2304 + 64 * (j))
#define XB_TOP      3328
#define XB_TOPGEN   3392
#define XCD_BAR_WORDS 3456
#define XB_SPIN_CAP (1u << 18)

__device__ __forceinline__ unsigned xb_ld(unsigned* p)              { return __hip_atomic_load(p, __ATOMIC_RELAXED, __HIP_MEMORY_SCOPE_AGENT); }
__device__ __forceinline__ unsigned xb_add(unsigned* p, unsigned v) { return __hip_atomic_fetch_add(p, v, __ATOMIC_RELAXED, __HIP_MEMORY_SCOPE_AGENT); }
__device__ __forceinline__ unsigned xb_xcc_id() { return (unsigned)__builtin_amdgcn_s_getreg((3 << 11) | 20) & 0xFu; }
#define XB_SPIN(cond, bar) do { unsigned _sp = 0; while (cond) { __builtin_amdgcn_s_sleep(1); \
    if ((++_sp & 255u) == 0u) { if (xb_ld(&(bar)[XB_TMO])) break; if (_sp > XB_SPIN_CAP) { atomicAdd(&(bar)[XB_TMO], 1u); break; } } } } while (0)

struct XcdBarrier {
    unsigned* bar; unsigned x;
    volatile LAS unsigned* st;
};

__device__ __forceinline__ XcdBarrier xcd_barrier_post(unsigned* bar, volatile LAS unsigned* st) {
    XcdBarrier b; b.bar = bar; b.x = xb_xcc_id(); b.st = st;
    if (threadIdx.x == 0) (void)xb_add(&bar[XB_XCNT(b.x)], 1u);
    return b;
}
__device__ __forceinline__ void xcd_barrier_complete(unsigned* bar, unsigned x, unsigned& nloc, unsigned& nx) {
    const unsigned G = gridDim.x * gridDim.y * gridDim.z;
    unsigned sum, cnt, mine, sp = 0u;
    for (;;) {
        sum = 0u; cnt = 0u; mine = 0u;
#pragma unroll
        for (unsigned j = 0; j < 16; ++j) { const unsigned c = xb_ld(&bar[XB_XCNT(j)]); sum += c; cnt += (c > 0u) ? 1u : 0u; mine = (j == x) ? c : mine; }
        if (sum == G) break;
        __builtin_amdgcn_s_sleep(1);
        if ((++sp & 255u) == 0u) { if (xb_ld(&bar[XB_TMO])) break; if (sp > XB_SPIN_CAP) { atomicAdd(&bar[XB_TMO], 1u); break; } }
    }
    nloc = mine > 0u ? mine : 1u; nx = cnt > 0u ? cnt : 1u;
}

__device__ __forceinline__ void xcd_barrier(const XcdBarrier& b) {
    asm volatile("s_waitcnt vmcnt(0)" ::: "memory");
    __syncthreads();
    int t0_ = threadIdx.x; asm volatile("" : "+v"(t0_));
    if (t0_ == 0) {
        unsigned* bar = b.bar;
        __builtin_amdgcn_s_waitcnt(0);
        unsigned nloc = b.st[0], nx = b.st[1];
        if (nloc == 0u) { xcd_barrier_complete(bar, b.x, nloc, nx); b.st[0] = nloc; b.st[1] = nx; }
        const unsigned old = xb_add(&bar[XB_XSUB(b.x)], 1u);
        const unsigned gen = old / nloc;
        if (old + 1u == (gen + 1u) * nloc) {
            __builtin_amdgcn_fence(__ATOMIC_RELEASE, "agent");
            asm volatile("s_waitcnt vmcnt(0)" ::: "memory");
            const unsigned og = xb_add(&bar[XB_TOP], 1u);
            const unsigned tg = og / nx;
            if (og + 1u == (tg + 1u) * nx) xb_add(&bar[XB_TOPGEN], 1u);
            else XB_SPIN(xb_ld(&bar[XB_TOPGEN]) == tg, bar);
            __builtin_amdgcn_fence(__ATOMIC_ACQUIRE, "agent");
            xb_add(&bar[XB_XGEN(b.x)], 1u);
            asm volatile("s_waitcnt vmcnt(0)" ::: "memory");
        } else {
            XB_SPIN(xb_ld(&bar[XB_XGEN(b.x)]) == gen, bar);
            __builtin_amdgcn_fence(__ATOMIC_ACQUIRE, "agent");
            asm volatile("s_waitcnt vmcnt(0)" ::: "memory");
        }
    }
    __syncthreads();
}
constexpr int NWAVES = 8;
constexpr int DM = 1024, SEQ = 16384, NBATCH = 2, MP = NBATCH * SEQ, DEC_B = 16, DEC_S = 32, PAST = 2048, MS = DEC_B * DEC_S, M = MP + MS;
constexpr int FF = 2816, FOX_COLS = 4112;
constexpr float RMS_EPS = 1e-6f, GN_EPS = 1e-5f, LOG2E = 1.4426950408889634f;
constexpr size_t MiB = 1u << 20;
constexpr size_t WS_CTL = 0, CTL_ZERO_BYTES = 1 * MiB;
constexpr size_t WS_WF = 1 * MiB;
constexpr size_t WS_WFI = 2 * MiB, WFI_STRIDE = 11 * MiB;
constexpr size_t WS_WFO = 90 * MiB, WFO_STRIDE = 11 * MiB / 2;
constexpr size_t WS_WXI = 134 * MiB, WXI_STRIDE = 8 * MiB;
constexpr size_t WS_WXO = 150 * MiB, WXO_STRIDE = 2 * MiB;
constexpr size_t WS_WRI = 154 * MiB, WRI_STRIDE = 12 * MiB;
constexpr size_t WS_WRO = 178 * MiB, WRO_STRIDE = 4 * MiB;
constexpr size_t WS_X = 186 * MiB;
constexpr size_t WS_XN = 316 * MiB;
constexpr size_t WS_BIG = 381 * MiB;
constexpr size_t WS_ACT = WS_BIG;
constexpr size_t WS_Q = WS_BIG, WS_K = WS_BIG + 65 * MiB, WS_V = WS_BIG + 130 * MiB, WS_OG = WS_BIG + 195 * MiB;
constexpr size_t WS_ND = WS_BIG + 260 * MiB;
constexpr size_t WS_LOGF = WS_BIG + 262 * MiB;
constexpr size_t WS_AO = WS_BIG + 270 * MiB;
constexpr size_t WS_T0 = WS_BIG + 266 * MiB;
constexpr size_t WS_THR = WS_BIG + 265 * MiB;
constexpr size_t WS_RQ = WS_BIG, WS_RK = WS_BIG + 65 * MiB, WS_RV = WS_BIG + 130 * MiB, WS_RG = WS_BIG + 260 * MiB, WS_RO = WS_BIG + 390 * MiB;
constexpr size_t WS_U = WS_BIG + 520 * MiB;
constexpr size_t WS_SSQP = WS_BIG + 552 * MiB;
constexpr size_t WS_SSQS = WS_BIG + 554 * MiB;
constexpr size_t WS_END = WS_BIG + 555 * MiB;
constexpr size_t O_YP = 0, O_YS = O_YP + (size_t)MP * DM, O_FKP = O_YS + (size_t)MS * DM, O_FVP = O_FKP + 2 * (size_t)MP * DM, O_FLP = O_FVP + 2 * (size_t)MP * DM,
                 O_RP = O_FLP + 2 * (size_t)MP * 16, O_FKS = O_RP + 2 * (size_t)NBATCH * 8 * 128 * 256, O_FVS = O_FKS + 2 * (size_t)MS * DM, O_FLS = O_FVS + 2 * (size_t)MS * DM,
                 O_RS = O_FLS + 2 * (size_t)MS * 16, O_END = O_RS + 2 * (size_t)DEC_B * 8 * 128 * 256;
static_assert(O_END == 180895744, "output size");
constexpr int CW_BAR = 4096;
constexpr int RING_OFF = 0, RING_BYTES = 131072;
constexpr int LDSCTL_OFF = RING_BYTES, MISC_OFF = LDSCTL_OFF + 320, GL_OFF = LDSCTL_OFF + 1024, RSB_OFF = LDSCTL_OFF + 2048;
constexpr int LDS_BYTES = 147456;
__device__ __forceinline__ float wave_sum(float v, int lane) {
#pragma unroll
    for (int o = 1; o < 64; o <<= 1) v += bperm(v, lane ^ o);
    return v;
}
__device__ __forceinline__ float wave_max(float v, int lane) {
#pragma unroll
    for (int o = 1; o < 64; o <<= 1) v = fmaxf(v, bperm(v, lane ^ o));
    return v;
}
template <bool PK = true>
__device__ __forceinline__ void wt_item(const float* W, int ldw, int K, bf16* WT, int k0, int n0, int srccol0, LAS float* scr, int lane, const float* gk = nullptr) {
#pragma unroll 8
    for (int i = 0; i < 32; ++i) { const int kk = 2 * i + (lane >> 5); const float w = W[(size_t)(k0 + kk) * ldw + srccol0 + (lane & 31)]; scr[kk * 33 + (lane & 31)] = gk ? w * gk[k0 + kk] : w; }
    LDS_WAIT(); asm volatile("" ::: "memory");
    const int c = lane & 7;
#pragma unroll
    for (int j = 0; j < 4; ++j) { const int n = (lane >> 3) + 8 * j; const LAS float* s = scr + (8 * c) * 33 + n;
        v4u o; o.x = pk2(s[0 * 33], s[1 * 33]); o.y = pk2(s[2 * 33], s[3 * 33]); o.z = pk2(s[4 * 33], s[5 * 33]); o.w = pk2(s[6 * 33], s[7 * 33]);
        *(GAS v4u*)(WT + (PK ? pg8::pk_elem(pg8::pk_slot(n0 + n), k0 + 8 * c, K >> 6) : (size_t)(n0 + n) * K + k0 + 8 * c)) = o; }
    LDS_WAIT(); asm volatile("" ::: "memory");
}
__device__ __forceinline__ int src_ffn_in(int n0) { const int pn = n0 >> 8, sel = (n0 >> 7) & 1, j0 = n0 & 127; return sel * FF + 128 * pn + j0; }
__device__ __forceinline__ int src_fox_in(int n0) { const int pn = n0 >> 8, bj = (n0 >> 7) & 1, wc = (n0 >> 5) & 3; return (pn >> 2) * 1024 + (4 * (pn & 3) + wc) * 64 + 32 * bj; }
__device__ __forceinline__ int src_ret_in(int n0) { const int pn = n0 >> 8; if (pn >= 8) return n0; const int bj = (n0 >> 7) & 1, wc = (n0 >> 5) & 3; return (pn >> 2) * 1024 + (2 * (pn & 3) + (wc >> 1)) * 128 + 64 * bj + 32 * (wc & 1); }

struct Ptrs {
    const float *x_prompt, *x_sample, *cache_k, *cache_v, *cache_lf, *state_ret, *norm_gains, *w_ffn_in, *w_ffn_out, *fox_w_in, *fox_b_f, *fox_qg, *fox_kg, *fox_w_out, *ret_w_in, *ret_w_out, *final_gain;
    float* out; unsigned char* ws;
};

__device__ __forceinline__ void p0_prologue(const Ptrs& P, LAS unsigned char* lds, int gw, int NGW, int wave, int lane) {
    LAS float* scr = (LAS float*)(lds + RING_OFF + wave * 16384);
    constexpr int I_FI = 16 * 176, I_FO = 44 * 32, I_XI = 16 * 128, I_XO = 16 * 32, I_RI = 16 * 192, I_RO = 32 * 32;
    constexpr int T_FI = 8 * I_FI, T_FO = T_FI + 8 * I_FO, T_XI = T_FO + 2 * I_XI, T_XO = T_XI + 2 * I_XO, T_RI = T_XO + 2 * I_RI, T_RO = T_RI + 2 * I_RO;
    for (int it = gw; it < T_RO; it += NGW) {
        if (it < T_FI) { const int w = it / I_FI, r = it % I_FI, kb = r / 176, nb = r % 176;
            wt_item(P.w_ffn_in + (size_t)w * 1024 * 5632, 5632, 1024, (bf16*)(P.ws + WS_WFI + w * WFI_STRIDE), 64 * kb, 32 * nb, src_ffn_in(32 * nb), scr, lane, P.norm_gains + (size_t)((w >> 1) * 3 + ((w & 1) ? 2 : 0)) * DM); }
        else if (it < T_FO) { const int q = it - T_FI, w = q / I_FO, r = q % I_FO, kb = r / 32, nb = r % 32;
            wt_item(P.w_ffn_out + (size_t)w * 2816 * 1024, 1024, 2816, (bf16*)(P.ws + WS_WFO + w * WFO_STRIDE), 64 * kb, 32 * nb, 32 * nb, scr, lane); }
        else if (it < T_XI) { const int q = it - T_FO, w = q / I_XI, r = q % I_XI, kb = r / 128, nb = r % 128;
            wt_item(P.fox_w_in + (size_t)w * 1024 * FOX_COLS, FOX_COLS, 1024, (bf16*)(P.ws + WS_WXI + w * WXI_STRIDE), 64 * kb, 32 * nb, src_fox_in(32 * nb), scr, lane, P.norm_gains + (size_t)((2 * w) * 3 + 1) * DM); }
        else if (it < T_XO) { const int q = it - T_XI, w = q / I_XO, r = q % I_XO, kb = r / 32, nb = r % 32;
            wt_item(P.fox_w_out + (size_t)w * 1024 * 1024, 1024, 1024, (bf16*)(P.ws + WS_WXO + w * WXO_STRIDE), 64 * kb, 32 * nb, 32 * nb, scr, lane); }
        else if (it < T_RI) { const int q = it - T_XO, w = q / I_RI, r = q % I_RI, kb = r / 192, nb = r % 192;
            wt_item(P.ret_w_in + (size_t)w * 1024 * 6144, 6144, 1024, (bf16*)(P.ws + WS_WRI + w * WRI_STRIDE), 64 * kb, 32 * nb, src_ret_in(32 * nb), scr, lane, P.norm_gains + (size_t)((2 * w + 1) * 3 + 1) * DM); }
        else { const int q = it - T_RI, w = q / I_RO, r = q % I_RO, kb = r / 32, nb = r % 32;
            wt_item(P.ret_w_out + (size_t)w * 2048 * 1024, 1024, 2048, (bf16*)(P.ws + WS_WRO + w * WRO_STRIDE), 64 * kb, 32 * nb, 32 * nb, scr, lane); }
    }
    { bf16* Xb = (bf16*)(P.ws + WS_X);
      for (int m = gw; m < M; m += NGW) {
        const GAS f32x4* xr = (const GAS f32x4*)((m < MP) ? P.x_prompt + (size_t)m * DM : P.x_sample + (size_t)(m - MP) * DM) + lane;
        float s2 = 0.f;
#pragma unroll
        for (int j = 0; j < 4; ++j) { const f32x4 v = xr[64 * j]; *(GAS unsigned long long*)(Xb + pg8::pk_elem(m, 4 * lane + 256 * j, 16)) = (unsigned long long)pk2(v.x, v.y) | ((unsigned long long)pk2(v.z, v.w) << 32); s2 += (v.x * v.x + v.y * v.y) + (v.z * v.z + v.w * v.w); }
        s2 = wave_sum(s2, lane);
        if (m < MP) { if (lane < 16) ((float*)(P.ws + WS_SSQP))[(size_t)m * 16 + lane] = lane == 0 ? s2 : 0.f; } else ((float*)(P.ws + WS_SSQS))[(size_t)(m - MP) * 64 + lane] = lane == 0 ? s2 : 0.f; } }
    float* WF = (float*)(P.ws + WS_WF);
    for (int i = gw * 64 + lane; i < 2 * 16 * 1024; i += NGW * 64) { const int jl = i >> 14, h = (i >> 10) & 15, k = i & 1023; WF[i] = P.fox_w_in[((size_t)jl * 1024 + k) * FOX_COLS + 4096 + h]; }
}

__device__ __forceinline__ float log_sigmoid(float z) { return fminf(z, 0.f) - log1pf(__expf(-fabsf(z))); }

__device__ __forceinline__ void forget_phase(const bf16* Xb, const float* gain, const float* WFl, const float* bfp, float* LOGF, float* outP, float* outS,
                                             LAS unsigned char* lds, int gw, int NGW, int tid, int lane) {
    LAS float* wl = (LAS float*)(lds + RING_OFF);
    for (int i = tid; i < 4096; i += NWAVES * 64) ((LAS f32x4*)wl)[i] = ((const f32x4*)WFl)[i];
    __syncthreads();
    f32x4 g[4];
#pragma unroll
    for (int j = 0; j < 4; ++j) g[j] = ((const f32x4*)gain)[lane + 64 * j];
    const bool b5 = (lane & 32) != 0, b4 = (lane & 16) != 0;
    unsigned long long xn[2][4];
#define FORGET_FETCH(m0_) do { _Pragma("unroll") for (int k = 0; k < 2; ++k) { const int m_ = (m0_) + k * NGW; const int mr = (m_ < M) ? m_ : 0; \
        _Pragma("unroll") for (int j = 0; j < 4; ++j) xn[k][j] = *(const GAS unsigned long long*)(Xb + pg8::pk_elem(mr, 4 * lane + 256 * j, 16)); } } while (0)
    FORGET_FETCH(gw);
    for (int m0 = gw; m0 < M; m0 += 2 * NGW) {
        f32x4 v[2][4]; float s2[2] = {0.f, 0.f};
#pragma unroll
        for (int k = 0; k < 2; ++k)
#pragma unroll
            for (int j = 0; j < 4; ++j) { const unsigned long long w = xn[k][j]; const unsigned lo = (unsigned)w, hh = (unsigned)(w >> 32);
                v[k][j] = (f32x4){__uint_as_float(lo << 16), __uint_as_float(lo & 0xffff0000u), __uint_as_float(hh << 16), __uint_as_float(hh & 0xffff0000u)};
                s2[k] += (v[k][j].x * v[k][j].x + v[k][j].y * v[k][j].y) + (v[k][j].z * v[k][j].z + v[k][j].w * v[k][j].w); }
        if (m0 + 2 * NGW < M) FORGET_FETCH(m0 + 2 * NGW);
#pragma unroll
        for (int o = 1; o < 64; o <<= 1) { s2[0] += bperm(s2[0], lane ^ o); s2[1] += bperm(s2[1], lane ^ o); }
#pragma unroll
        for (int k = 0; k < 2; ++k) { const float rstd = __builtin_amdgcn_rsqf(s2[k] * (1.f / DM) + RMS_EPS);
#pragma unroll
            for (int j = 0; j < 4; ++j) v[k][j] = v[k][j] * rstd * g[j]; }
#pragma unroll 1
        for (int h0 = 0; h0 < 16; h0 += 4) {
            float p[2][4];
#pragma unroll
            for (int q = 0; q < 4; ++q) { p[0][q] = 0.f; p[1][q] = 0.f;
#pragma unroll
                for (int j = 0; j < 4; ++j) { const f32x4 w = ((const LAS f32x4*)(wl + (h0 + q) * 1024))[lane + 64 * j];
#pragma unroll
                    for (int k = 0; k < 2; ++k) p[k][q] += (v[k][j].x * w.x + v[k][j].y * w.y) + (v[k][j].z * w.z + v[k][j].w * w.w); } }
#pragma unroll
            for (int k = 0; k < 2; ++k) {
                const float s0 = b5 ? p[k][0] : p[k][2], s1 = b5 ? p[k][1] : p[k][3], k0 = b5 ? p[k][2] : p[k][0], k1 = b5 ? p[k][3] : p[k][1];
                const float q0 = k0 + bperm(s0, lane ^ 32), q1 = k1 + bperm(s1, lane ^ 32);
                float r = (b4 ? q1 : q0) + bperm(b4 ? q0 : q1, lane ^ 16);
                r += bperm(r, lane ^ 8); r += bperm(r, lane ^ 4); r += bperm(r, lane ^ 2); r += bperm(r, lane ^ 1);
                if ((lane & 15) == 0) {
                    const int hd = h0 + (lane >> 4); const int m = m0 + k * NGW;
                    if (m < M) { const float lf = log_sigmoid(r + bfp[hd]); LOGF[(size_t)m * 16 + hd] = lf;
                        if (m < MP) outP[(size_t)m * 16 + hd] = lf; else outS[(size_t)(m - MP) * 16 + hd] = lf; } }
            }
        }
    }
}
#undef FORGET_FETCH
__device__ __forceinline__ void final_norm_phase(const bf16* X, const float* gain, float* yP, float* yS, int gw, int NGW, int lane) {
    f32x4 g[4];
#pragma unroll
    for (int j = 0; j < 4; ++j) g[j] = ((const f32x4*)gain)[lane + 64 * j];
    unsigned long long xn[4];
#pragma unroll
    for (int j = 0; j < 4; ++j) xn[j] = *(const GAS unsigned long long*)(X + pg8::pk_elem(gw < M ? gw : 0, 4 * lane + 256 * j, 16));
    for (int m = gw; m < M; m += NGW) {
        f32x4 v[4]; float s2 = 0.f; unsigned long long xc[4];
#pragma unroll
        for (int j = 0; j < 4; ++j) xc[j] = xn[j];
        if (m + NGW < M) {
#pragma unroll
            for (int j = 0; j < 4; ++j) xn[j] = *(const GAS unsigned long long*)(X + pg8::pk_elem(m + NGW, 4 * lane + 256 * j, 16)); }
#pragma unroll
        for (int j = 0; j < 4; ++j) { const unsigned long long w = xc[j]; const unsigned lo = (unsigned)w, hh = (unsigned)(w >> 32);
            v[j] = (f32x4){__uint_as_float(lo << 16), __uint_as_float(lo & 0xffff0000u), __uint_as_float(hh << 16), __uint_as_float(hh & 0xffff0000u)};
            s2 += (v[j].x * v[j].x + v[j].y * v[j].y) + (v[j].z * v[j].z + v[j].w * v[j].w); }
        const float rstd = 1.0f / sqrtf(wave_sum(s2, lane) * (1.f / DM) + RMS_EPS);
        GAS f32x4* o = (GAS f32x4*)((m < MP ? yP + (size_t)m * DM : yS + (size_t)(m - MP) * DM)) + lane;
#pragma unroll
        for (int j = 0; j < 4; ++j) __builtin_nontemporal_store(v[j] * rstd * g[j], (f32x4*)&o[64 * j]);
    }
}
__device__ __forceinline__ void cumsum_unit(const float* LOGF, float* ND, int bh, LAS unsigned char* lds, int tid, int wave, int lane, float margin, int* T0) {
    const int b = bh >> 4, h = bh & 15; LAS float* wt = (LAS float*)(lds + RING_OFF);
    LAS float* te = (LAS float*)(lds + RING_OFF + 1024); LAS float* q0 = (LAS float*)(lds + RING_OFF + 2048);
    const float* src = LOGF + ((size_t)b * SEQ + (size_t)tid * 32) * 16 + h;
    float v[32]; float run = 0.f;
#pragma unroll
    for (int i = 0; i < 32; ++i) { run += src[(size_t)i * 16]; v[i] = run; }
    float inc = run;
#pragma unroll
    for (int o = 1; o < 64; o <<= 1) { const float t = bperm(inc, lane - o); if (lane >= o) inc += t; }
    if (lane == 63) wt[wave] = inc;
    __syncthreads();
    float base = inc - run;
    for (int w = 0; w < wave; ++w) base += wt[w];
    float* dst = ND + (size_t)bh * SEQ + (size_t)tid * 32;
#pragma unroll
    for (int i = 0; i < 32; i += 4) { f32x4 o; o.x = -LOG2E * (base + v[i]); o.y = -LOG2E * (base + v[i + 1]); o.z = -LOG2E * (base + v[i + 2]); o.w = -LOG2E * (base + v[i + 3]); *(f32x4*)(dst + i) = o; }
    if (tid & 1) te[tid >> 1] = -LOG2E * (base + v[31]);
    if ((tid & 7) == 0) q0[tid >> 3] = -LOG2E * (base + v[0]);
    __syncthreads();
    { const int qb = tid >> 3, part = tid & 7, ntf = 4 * qb + 4; const float thr = q0[qb] - margin; int cnt = 0;
#pragma unroll
      for (int k = 0; k < 32; ++k) { const int t = 32 * part + k; cnt += ((t < ntf) && (te[t] <= thr)) ? 1 : 0; }
      cnt += __builtin_amdgcn_ds_bpermute((lane ^ 1) << 2, cnt); cnt += __builtin_amdgcn_ds_bpermute((lane ^ 2) << 2, cnt); cnt += __builtin_amdgcn_ds_bpermute((lane ^ 4) << 2, cnt);
      int t0 = cnt & ~1; if (t0 > ntf - 4) t0 = ntf - 4;
      if (part == 0) T0[bh * 64 + qb] = t0; }
    __syncthreads();
}

template <bool PKA, bool PKB>
__device__ __forceinline__ void small_gemm_resid(const bf16* A, const bf16* Bt, int K, bf16* X, float s, int unit, LAS unsigned char* lds, float* SSQS) {
    int tid_ = threadIdx.x; asm volatile("" : "+v"(tid_)); const int tid = tid_, lane = tid & 63, wid = __builtin_amdgcn_readfirstlane(tid >> 6);
    const int row0 = MP + 64 * (unit >> 5), col0 = 32 * (unit & 31), fr = lane & 15, fq = lane >> 4;
    f32x4 acc[4][2];
#pragma unroll
    for (int rt = 0; rt < 4; ++rt)
#pragma unroll
        for (int ct = 0; ct < 2; ++ct) acc[rt][ct] = (f32x4){0.f, 0.f, 0.f, 0.f};
    const int kw = K >> 3;
    unsigned short xin[4];
#pragma unroll
    for (int q = 0; q < 4; ++q) { const int idx = tid + 512 * q, l2 = idx & 63, r = (idx >> 6) & 3, ct = (idx >> 8) & 1, rt = idx >> 9;
        xin[q] = X[pg8::pk_elem(row0 + 16 * rt + 4 * (l2 >> 4) + r, col0 + 16 * ct + (l2 & 15), 16)]; }
    const bf16* ap = A + (size_t)(row0 + fr) * K + wid * kw + 8 * fq;
    const bf16* bp = Bt + (size_t)(col0 + fr) * K + wid * kw + 8 * fq;
    for (int ks = 0; ks < kw; ks += 128) {
        bf16x8 a[4][4], b[4][2];
#pragma unroll
        for (int t = 0; t < 4; ++t) if (ks + 32 * t < kw) {
#pragma unroll
            for (int rt = 0; rt < 4; ++rt) a[t][rt] = PKA ? *(const bf16x8*)(A + pg8::pk_elem(row0 + fr + 16 * rt, wid * kw + 8 * fq + ks + 32 * t, K >> 6)) : *(const bf16x8*)(ap + (size_t)(16 * rt) * K + ks + 32 * t);
#pragma unroll
            for (int ct = 0; ct < 2; ++ct) b[t][ct] = PKB ? *(const bf16x8*)(Bt + pg8::pk_elem(pg8::pk_slot(col0 + fr + 16 * ct), wid * kw + 8 * fq + ks + 32 * t, K >> 6)) : *(const bf16x8*)(bp + (size_t)(16 * ct) * K + ks + 32 * t); }
#pragma unroll
        for (int t = 0; t < 4; ++t) if (ks + 32 * t < kw) {
#pragma unroll
            for (int rt = 0; rt < 4; ++rt)
#pragma unroll
                for (int ct = 0; ct < 2; ++ct) acc[rt][ct] = __builtin_amdgcn_mfma_f32_16x16x32_bf16(a[t][rt], b[t][ct], acc[rt][ct], 0, 0, 0); }
    }
    LAS float* red = (LAS float*)(lds + RING_OFF);
#pragma unroll
    for (int rt = 0; rt < 4; ++rt)
#pragma unroll
        for (int ct = 0; ct < 2; ++ct)
#pragma unroll
            for (int r = 0; r < 4; ++r) red[((wid * 8 + rt * 2 + ct) * 4 + r) * 64 + lane] = acc[rt][ct][r];
    __syncthreads();
#pragma unroll
    for (int q = 0; q < 4; ++q) { const int idx = tid + 512 * q, l2 = idx & 63, r = (idx >> 6) & 3, ct = (idx >> 8) & 1, rt = idx >> 9;
        float sum = 0.f;
#pragma unroll
        for (int w = 0; w < 8; ++w) sum += red[w * 2048 + idx];
        const size_t o = pg8::pk_elem(row0 + 16 * rt + 4 * (l2 >> 4) + r, col0 + 16 * ct + (l2 & 15), 16);
        const float v = __uint_as_float((unsigned)xin[q] << 16) + s * sum; X[o] = (bf16)f2bf(v);
        float ss = v * v; ss += bperm(ss, lane ^ 1); ss += bperm(ss, lane ^ 2); ss += bperm(ss, lane ^ 4); ss += bperm(ss, lane ^ 8);
        if ((l2 & 15) == 0) SSQS[(size_t)(row0 - MP + 16 * rt + 4 * (l2 >> 4) + r) * 64 + 2 * (unit & 31) + ct] = ss; }
    __syncthreads();
}

__device__ __forceinline__ void kv_out_chunk(const bf16* Kb, const bf16* Vb, float* kP, float* vP, float* kS, float* vS, int c) {
    int tid_ = threadIdx.x; asm volatile("" : "+v"(tid_)); const int tid = tid_;
#pragma unroll 1
    for (int base = 0; base < 65 * 512; base += 22 * 512) {
        unsigned long long k[22], v[22];
#pragma unroll
        for (int u = 0; u < 22; ++u) { const int g = base + u * 512 + tid; const int gc = g < 65 * 512 ? g : 65 * 512 - 1; const size_t off = (size_t)(130 * c + (gc >> 8)) * DM + (gc & 255) * 4; k[u] = *(const unsigned long long*)(Kb + off); v[u] = *(const unsigned long long*)(Vb + off); }
        asm volatile("" ::: "memory");
#pragma unroll
        for (int u = 0; u < 22; ++u) { if (base + u * 512 >= 65 * 512) break; const int g = base + u * 512 + tid; const int row = 130 * c + (g >> 8); const size_t off = (size_t)row * DM + (g & 255) * 4;
            float* ko = (row < MP) ? kP + off : kS + (off - (size_t)MP * DM); float* vo = (row < MP) ? vP + off : vS + (off - (size_t)MP * DM);
            const unsigned k0 = (unsigned)k[u], k1 = (unsigned)(k[u] >> 32), v0 = (unsigned)v[u], v1 = (unsigned)(v[u] >> 32);
            __builtin_nontemporal_store((f32x4){__uint_as_float(k0 << 16), __uint_as_float(k0 & 0xffff0000u), __uint_as_float(k1 << 16), __uint_as_float(k1 & 0xffff0000u)}, (f32x4*)ko);
            __builtin_nontemporal_store((f32x4){__uint_as_float(v0 << 16), __uint_as_float(v0 & 0xffff0000u), __uint_as_float(v1 << 16), __uint_as_float(v1 & 0xffff0000u)}, (f32x4*)vo); }
    }
}
namespace smp {
typedef short bf16x8 __attribute__((ext_vector_type(8)));
typedef float f32x16 __attribute__((ext_vector_type(16)));
constexpr int L_ND = 0;
constexpr int L_WT = 8448;
constexpr int L_LP = 8704;
constexpr int L_OP = 16384;
constexpr int L_END = L_OP + 65536;
__device__ __forceinline__ int crow(int r, int hi) { return (r & 3) + 8 * (r >> 2) + 4 * hi; }
__device__ __forceinline__ bf16x8 cvt8(const f32x4 a, const f32x4 b) { const u32x4q w = {pkq(a[0], a[1]), pkq(a[2], a[3]), pkq(b[0], b[1]), pkq(b[2], b[3])}; return __builtin_bit_cast(bf16x8, w); }

__device__ __forceinline__ void unit(int jl, int b, int h, const float* kcache, const float* vcache, const float* lfcache, const float* LOGF,
                                     const bf16* Q, const bf16* Kb, const bf16* Vb, const bf16* OG, bf16* OUT, LAS unsigned char* lds) {
    int tid_ = threadIdx.x; asm volatile("" : "+v"(tid_)); const int tid = tid_, lane = tid & 63, wid = __builtin_amdgcn_readfirstlane(tid >> 6);
    const int r32 = lane & 31, hi = lane >> 5;
    LAS float* nd = (LAS float*)(lds + L_ND); LAS float* wt = (LAS float*)(lds + L_WT); LAS float* lp = (LAS float*)(lds + L_LP); LAS float* op = (LAS float*)(lds + L_OP);
    const size_t cb = ((size_t)jl * DEC_B + b) * PAST;
    {
        float v[5]; float run = 0.f;
#pragma unroll
        for (int i = 0; i < 5; ++i) { const int j = tid * 5 + i; float lf = 0.f;
            if (j < PAST) lf = lfcache[(cb + j) * 16 + h]; else if (j < PAST + DEC_S) lf = LOGF[(size_t)(MP + b * DEC_S + (j - PAST)) * 16 + h];
            run += lf; v[i] = run; }
        float inc = run;
#pragma unroll
        for (int o = 1; o < 64; o <<= 1) { const float t = bperm(inc, lane - o); if (lane >= o) inc += t; }
        if (lane == 63) wt[wid] = inc;
        __syncthreads();
        float base = inc - run;
        for (int w = 0; w < wid; ++w) base += wt[w];
#pragma unroll
        for (int i = 0; i < 5; ++i) { const int j = tid * 5 + i; if (j < PAST + DEC_S) nd[j] = -LOG2E * (base + v[i]); }
        __syncthreads();
    }
    const size_t qrow = (size_t)(MP + b * DEC_S + r32) * DM + h * 64;
    bf16x8 qf[4];
#pragma unroll
    for (int s = 0; s < 4; ++s) qf[s] = *(const bf16x8*)(Q + qrow + 16 * s + 8 * hi);
    const float ndi = nd[PAST + r32];
    f32x16 o0 = {}, o1 = {}; float lsum = 0.f;
#define SMP_SCORES(T_, MASK_) \
        f32x16 S; \
        _Pragma("unroll") for (int r = 0; r < 16; ++r) S[r] = -ndi; \
        _Pragma("unroll") for (int s = 0; s < 4; ++s) S = __builtin_amdgcn_mfma_f32_32x32x16_bf16(ka[s], qf[s], S, 0, 0, 0); \
        _Pragma("unroll") for (int g = 0; g < 4; ++g) { const f32x4 bq = *(const LAS f32x4*)(nd + (T_) * 32 + 8 * g + 4 * hi); \
            _Pragma("unroll") for (int e = 0; e < 4; ++e) { float x = S[4 * g + e] + bq[e]; if ((MASK_) && (8 * g + 4 * hi + e) > r32) x = -INFINITY; const float p = __builtin_amdgcn_exp2f(x); S[4 * g + e] = p; lsum += p; } } \
        const bf16x8 pa0 = cvt8((f32x4){S[0], S[1], S[2], S[3]}, (f32x4){S[4], S[5], S[6], S[7]}), pa1 = cvt8((f32x4){S[8], S[9], S[10], S[11]}, (f32x4){S[12], S[13], S[14], S[15]});
    for (int T = wid; T < 64; T += NWAVES) {
        const float* kp = kcache + ((cb + (size_t)T * 32 + r32) * 16 + h) * 64 + 8 * hi;
        f32x4 kr[8]; float vr[2][2][8];
#pragma unroll
        for (int s = 0; s < 4; ++s) { kr[2 * s] = *(const f32x4*)(kp + 16 * s); kr[2 * s + 1] = *(const f32x4*)(kp + 16 * s + 4); }
#pragma unroll
        for (int sp = 0; sp < 2; ++sp)
#pragma unroll
            for (int db = 0; db < 2; ++db)
#pragma unroll
                for (int jj = 0; jj < 8; ++jj) vr[sp][db][jj] = vcache[((cb + (size_t)T * 32 + 16 * sp + 8 * (jj >> 2) + 4 * hi + (jj & 3)) * 16 + h) * 64 + 32 * db + r32];
        bf16x8 ka[4];
#pragma unroll
        for (int s = 0; s < 4; ++s) ka[s] = cvt8(kr[2 * s], kr[2 * s + 1]);
        SMP_SCORES(T, false)
#pragma unroll
        for (int sp = 0; sp < 2; ++sp) { const bf16x8 pa = sp == 0 ? pa0 : pa1;
            const bf16x8 v0 = cvt8((f32x4){vr[sp][0][0], vr[sp][0][1], vr[sp][0][2], vr[sp][0][3]}, (f32x4){vr[sp][0][4], vr[sp][0][5], vr[sp][0][6], vr[sp][0][7]});
            const bf16x8 v1 = cvt8((f32x4){vr[sp][1][0], vr[sp][1][1], vr[sp][1][2], vr[sp][1][3]}, (f32x4){vr[sp][1][4], vr[sp][1][5], vr[sp][1][6], vr[sp][1][7]});
            o0 = __builtin_amdgcn_mfma_f32_32x32x16_bf16(pa, v0, o0, 0, 0, 0); o1 = __builtin_amdgcn_mfma_f32_32x32x16_bf16(pa, v1, o1, 0, 0, 0); }
    }
    if (wid == 0) {
        const int T = 64;
        const bf16* kp = Kb + (size_t)(MP + b * DEC_S + r32) * DM + h * 64 + 8 * hi;
        bf16x8 ka[4];
#pragma unroll
        for (int s = 0; s < 4; ++s) ka[s] = *(const bf16x8*)(kp + 16 * s);
        bf16x8 vf[2][2];
#pragma unroll
        for (int sp = 0; sp < 2; ++sp)
#pragma unroll
            for (int db = 0; db < 2; ++db) { bf16x8 t;
#pragma unroll
                for (int jj = 0; jj < 8; ++jj) t[jj] = (short)Vb[(size_t)(MP + b * DEC_S + 16 * sp + 8 * (jj >> 2) + 4 * hi + (jj & 3)) * DM + h * 64 + 32 * db + r32];
                vf[sp][db] = t; }
        SMP_SCORES(T, true)
        o0 = __builtin_amdgcn_mfma_f32_32x32x16_bf16(pa0, vf[0][0], o0, 0, 0, 0); o1 = __builtin_amdgcn_mfma_f32_32x32x16_bf16(pa0, vf[0][1], o1, 0, 0, 0);
        o0 = __builtin_amdgcn_mfma_f32_32x32x16_bf16(pa1, vf[1][0], o0, 0, 0, 0); o1 = __builtin_amdgcn_mfma_f32_32x32x16_bf16(pa1, vf[1][1], o1, 0, 0, 0);
    }
#undef SMP_SCORES
    lsum += bperm(lsum, lane ^ 32);
    if (hi == 0) lp[wid * 32 + r32] = lsum;
#pragma unroll
    for (int r = 0; r < 16; ++r) { op[((wid * 2 + 0) * 16 + r) * 64 + lane] = o0[r]; op[((wid * 2 + 1) * 16 + r) * 64 + lane] = o1[r]; }
    __syncthreads();
    {
        const int i = tid >> 4, d0 = 4 * (tid & 15);
        float l = 0.f;
#pragma unroll
        for (int w = 0; w < 8; ++w) l += lp[w * 32 + i];
        const float rl = 1.0f / l;
        const int hi2 = (i >> 2) & 1, r = (i & 3) + 4 * (i >> 3);
        float acc[4] = {0.f, 0.f, 0.f, 0.f};
#pragma unroll
        for (int w = 0; w < 8; ++w)
#pragma unroll
            for (int e = 0; e < 4; ++e) { const int d = d0 + e; acc[e] += op[((w * 2 + (d >> 5)) * 16 + r) * 64 + (d & 31) + 32 * hi2]; }
        const size_t orow = (size_t)(MP + b * DEC_S + i) * DM + h * 64 + d0;
        const unsigned long long gw8 = *(const unsigned long long*)(OG + orow);
        const unsigned g0 = (unsigned)gw8, g1 = (unsigned)(gw8 >> 32);
        const float y0 = acc[0] * rl * __uint_as_float(g0 << 16), y1 = acc[1] * rl * __uint_as_float(g0 & 0xffff0000u), y2 = acc[2] * rl * __uint_as_float(g1 << 16), y3 = acc[3] * rl * __uint_as_float(g1 & 0xffff0000u);
        *(unsigned long long*)(OUT + orow) = (unsigned long long)pkq(y0, y1) | ((unsigned long long)pkq(y2, y3) << 32);
    }
    __syncthreads();
}
}

namespace ret {
typedef short bf16x8 __attribute__((ext_vector_type(8)));
typedef short s16x4 __attribute__((ext_vector_type(4)));
typedef float f32x16 __attribute__((ext_vector_type(16)));
constexpr int KS = 272, KDS = 320, VS = 576, OSS = 528;
constexpr int L_QD = 0, L_K = 17408, L_KD = 34816, L_V = 55296, L_OS = 92160, L_END = 125952, L_XF = 131072 + 2048;
constexpr int GCH = 16;
__device__ __forceinline__ int crow(int r, int hi) { return (r & 3) + 8 * (r >> 2) + 4 * hi; }
__device__ __forceinline__ s16x4 trd(const LAS unsigned char* p) { return __builtin_bit_cast(s16x4, __builtin_amdgcn_ds_read_tr16_b64_v4i16((LAS v4i16q*)p)); }
__device__ __forceinline__ bf16x8 cat(s16x4 a, s16x4 b) { return (bf16x8){a[0], a[1], a[2], a[3], b[0], b[1], b[2], b[3]}; }
__device__ __forceinline__ u32x4q scale8(u32x4q w, float f) { u32x4q o;
#pragma unroll
    for (int e = 0; e < 4; ++e) o[e] = pkq(__uint_as_float(w[e] << 16) * f, __uint_as_float(w[e] & 0xffff0000u) * f);
    return o; }
__device__ __forceinline__ bf16x8 pack8(const f32x16& x, int b) { const u32x4q w = {pkq(x[b], x[b + 1]), pkq(x[b + 2], x[b + 3]), pkq(x[b + 4], x[b + 5]), pkq(x[b + 6], x[b + 7])}; return __builtin_bit_cast(bf16x8, w); }

template <bool WITH_OUT>
__device__ __forceinline__ void unit(LAS unsigned char* lds, int rowbase, int nch, int n, int h, float lg2, const bf16* RQ, const bf16* RK, const bf16* RV, const bf16* RG, bf16* RO,
                                     const float* Sin, float* Sout) {
    int tid_ = threadIdx.x; asm volatile("" : "+v"(tid_)); const int tid = tid_, lane = tid & 63, w = __builtin_amdgcn_readfirstlane(tid >> 6);
    const int r32 = lane & 31, hi = lane >> 5, li = lane & 15, grp = (lane >> 4) & 1;
    const int qrow0 = tid >> 4, qch = tid & 15, vrow0 = tid >> 5, vch = tid & 31;
    const float sdec = __builtin_amdgcn_exp2f(lg2 * (float)n);
    f32x16 S[4];
#pragma unroll
    for (int d = 0; d < 4; ++d)
#pragma unroll
        for (int r = 0; r < 16; ++r) S[d][r] = Sin ? Sin[(size_t)(32 * d + crow(r, hi)) * 256 + 32 * w + r32] : 0.f;
    const int xjb = (w >> 1) & 1, xib = w & 1;
    const int gtok = tid >> 3, gseg = tid & 7;
    u32x4q rq[2] = {{0u, 0u, 0u, 0u}, {0u, 0u, 0u, 0u}}, rk[2], rv[4];
#define RET_GLOAD(c_) do { const size_t tb_ = (size_t)rowbase + (size_t)(c_) * 64; \
        _Pragma("unroll") for (int u = 0; u < 2; ++u) { const int row_ = qrow0 + 32 * u; const bool ok_ = row_ < n; \
            rk[u] = ok_ ? *(const u32x4q*)(RK + (tb_ + row_) * 1024 + h * 128 + qch * 8) : (u32x4q){0u, 0u, 0u, 0u}; \
            if (WITH_OUT) rq[u] = ok_ ? *(const u32x4q*)(RQ + (tb_ + row_) * 1024 + h * 128 + qch * 8) : (u32x4q){0u, 0u, 0u, 0u}; } \
        _Pragma("unroll") for (int u = 0; u < 4; ++u) { const int row_ = vrow0 + 16 * u; \
            rv[u] = (row_ < n) ? *(const u32x4q*)(RV + (tb_ + row_) * 2048 + h * 256 + vch * 8) : (u32x4q){0u, 0u, 0u, 0u}; } } while (0)
#define RET_GN(cc_) do { float v[32]; float sm = 0.f; \
        _Pragma("unroll") for (int u = 0; u < 4; ++u) { const u32x4q o = *(const LAS u32x4q*)(lds + L_OS + gtok * OSS + gseg * 64 + 16 * u); \
            _Pragma("unroll") for (int e = 0; e < 4; ++e) { v[8 * u + 2 * e] = __uint_as_float(o[e] << 16); v[8 * u + 2 * e + 1] = __uint_as_float(o[e] & 0xffff0000u); sm += v[8 * u + 2 * e] + v[8 * u + 2 * e + 1]; } } \
        sm += bperm(sm, lane ^ 1); sm += bperm(sm, lane ^ 2); sm += bperm(sm, lane ^ 4); \
        const float mu = sm * (1.f / 256.f); float qv = 0.f; \
        _Pragma("unroll") for (int k = 0; k < 32; ++k) { v[k] -= mu; qv += v[k] * v[k]; } \
        qv += bperm(qv, lane ^ 1); qv += bperm(qv, lane ^ 2); qv += bperm(qv, lane ^ 4); \
        const float rstd = __builtin_amdgcn_rsqf(qv * (1.f / 256.f) + GN_EPS); \
        if (gtok < n) { const int orow_ = rowbase + (cc_) * 64 + gtok;        \
            _Pragma("unroll") for (int u = 0; u < 4; ++u) { u32x4q o; \
                _Pragma("unroll") for (int e = 0; e < 4; ++e) o[e] = pkq(v[8 * u + 2 * e] * rstd * __uint_as_float(rg[u][e] << 16), v[8 * u + 2 * e + 1] * rstd * __uint_as_float(rg[u][e] & 0xffff0000u)); \
                *(u32x4q*)(RO + pg8::pk_elem(orow_, h * 256 + gseg * 32 + 8 * u, 32)) = o; } } } while (0)
#define RET_GATE(cc_) do { if (gtok < n) { const size_t gb = ((size_t)rowbase + (size_t)(cc_) * 64 + gtok) * 2048 + h * 256 + gseg * 32; \
        _Pragma("unroll") for (int u = 0; u < 4; ++u) rg[u] = *(const u32x4q*)(RG + gb + 8 * u); } } while (0)
    RET_GLOAD(0);
    u32x4q rg[4] = {{0u, 0u, 0u, 0u}, {0u, 0u, 0u, 0u}, {0u, 0u, 0u, 0u}, {0u, 0u, 0u, 0u}};
    for (int c = 0; c < nch; ++c) {
#pragma unroll
        for (int u = 0; u < 2; ++u) { const int row = qrow0 + 32 * u;
            *(LAS u32x4q*)(lds + L_KD + row * KDS + qch * 16) = scale8(rk[u], (row < n) ? __builtin_amdgcn_exp2f(lg2 * (float)(n - row)) : 0.f);
            if (WITH_OUT) { *(LAS u32x4q*)(lds + L_K + row * KS + qch * 16) = rk[u]; *(LAS u32x4q*)(lds + L_QD + row * KS + qch * 16) = scale8(rq[u], __builtin_amdgcn_exp2f(lg2 * (float)row)); } }
#pragma unroll
        for (int u = 0; u < 4; ++u) *(LAS u32x4q*)(lds + L_V + (vrow0 + 16 * u) * VS + vch * 16) = rv[u];
        if (c + 1 < nch) RET_GLOAD(c + 1);
        __syncthreads();
        if (WITH_OUT && c > 0) RET_GN(c - 1);
        if (WITH_OUT) RET_GATE(c);
        f32x16 O[2] = {{}, {}};
        if (WITH_OUT) {
            if (w < 4) {
                f32x16 X = {};
#pragma unroll
                for (int s = 0; s < 8; ++s) { const bf16x8 a = *(const LAS bf16x8*)(lds + L_K + (32 * xjb + r32) * KS + (16 * s + 8 * hi) * 2), bq = *(const LAS bf16x8*)(lds + L_QD + (32 * xib + r32) * KS + (16 * s + 8 * hi) * 2);
                    X = __builtin_amdgcn_mfma_f32_32x32x16_bf16(a, bq, X, 0, 0, 0); }
#pragma unroll
                for (int r = 0; r < 16; ++r) { const int j = 32 * xjb + crow(r, hi), i = 32 * xib + r32; X[r] *= __builtin_amdgcn_exp2f(lg2 * (float)(i >= j ? -j : j - 2 * i)); }
                *(LAS bf16x8*)(lds + L_XF + (w * 2 + 0) * 1024 + lane * 16) = pack8(X, 0);
                *(LAS bf16x8*)(lds + L_XF + (w * 2 + 1) * 1024 + lane * 16) = pack8(X, 8);
            }
#pragma unroll
            for (int d = 0; d < 4; ++d)
#pragma unroll
                for (int sp = 0; sp < 2; ++sp) { const bf16x8 sfr = pack8(S[d], 8 * sp);
#pragma unroll
                    for (int ib = 0; ib < 2; ++ib) { const LAS unsigned char* qp = lds + L_QD + (32 * ib + r32) * KS + (32 * d + 16 * sp + 4 * hi) * 2;
                        const s16x4 a0 = *(const LAS s16x4*)qp, a1 = *(const LAS s16x4*)(qp + 16);
                        O[ib] = __builtin_amdgcn_mfma_f32_32x32x16_bf16(cat(a0, a1), sfr, O[ib], 0, 0, 0); } }
        }
        bf16x8 vf[4];
#pragma unroll
        for (int q = 0; q < 4; ++q) { const LAS unsigned char* vp = lds + L_V + (16 * q + 4 * hi + (li >> 2)) * VS + (32 * w + 16 * grp + 4 * (li & 3)) * 2; vf[q] = cat(trd(vp), trd(vp + 8 * VS)); }
#pragma unroll
        for (int d = 0; d < 4; ++d) {
#pragma unroll
            for (int r = 0; r < 16; ++r) S[d][r] *= sdec;
#pragma unroll
            for (int q = 0; q < 4; ++q) { const LAS unsigned char* kp = lds + L_KD + (16 * q + 4 * hi + (li >> 2)) * KDS + (32 * d + 16 * grp + 4 * (li & 3)) * 2;
                S[d] = __builtin_amdgcn_mfma_f32_32x32x16_bf16(cat(trd(kp), trd(kp + 8 * KDS)), vf[q], S[d], 0, 0, 0); }
        }
        __syncthreads();
        if (WITH_OUT) {
#pragma unroll
            for (int q = 0; q < 4; ++q)
#pragma unroll
                for (int ib = 0; ib < 2; ++ib) { const bf16x8 pa = *(const LAS bf16x8*)(lds + L_XF + (((q >> 1) * 2 + ib) * 2 + (q & 1)) * 1024 + lane * 16);
                    O[ib] = __builtin_amdgcn_mfma_f32_32x32x16_bf16(pa, vf[q], O[ib], 0, 0, 0); }
#pragma unroll
            for (int ib = 0; ib < 2; ++ib)
#pragma unroll
                for (int r = 0; r < 16; ++r) *(LAS unsigned short*)(lds + L_OS + (32 * ib + crow(r, hi)) * OSS + (32 * w + r32) * 2) = (unsigned short)(pkq(O[ib][r], 0.f) & 0xffffu);
        }
    }
    if (WITH_OUT) {
        __syncthreads();
        RET_GN(nch - 1);
    }
    if (Sout) {
#pragma unroll
        for (int d = 0; d < 4; ++d)
#pragma unroll
            for (int r = 0; r < 16; ++r) Sout[(size_t)(32 * d + crow(r, hi)) * 256 + 32 * w + r32] = S[d][r];
    }
    __syncthreads();
#undef RET_GLOAD
#undef RET_GN
#undef RET_GATE
}
}
__device__ __forceinline__ float ret_lg2(int h) { return log1pf(-__builtin_amdgcn_exp2f((float)(-5 - h))) * LOG2E; }
__device__ __forceinline__ void ret_scan_phase(float* U, float* outP  , int gtid, int nthreads) {
    for (int e = gtid; e < 16 * 32768; e += nthreads) {
        const int bh = e >> 15, x = e & 32767, h = bh & 7;
        const float dec = __builtin_amdgcn_exp2f(ret_lg2(h) * (float)(ret::GCH * 64));
        float* p = U + (size_t)bh * 16 * 32768 + x;
        float u[16];
#pragma unroll
        for (int sc = 0; sc < 16; ++sc) u[sc] = p[(size_t)sc * 32768];
        float s = 0.f;
#pragma unroll
        for (int sc = 0; sc < 16; ++sc) { p[(size_t)sc * 32768] = s; s = s * dec + u[sc]; }
        outP[e] = s;
    }
}
#ifndef REP_ATTN
#define REP_ATTN 1
#endif
#ifndef REP_RET
#define REP_RET 1
#endif
#ifndef REP_FFNIN
#define REP_FFNIN 1
#endif
#ifndef REP_P0
#define REP_P0 1
#endif
#ifndef REP_FFNOUT
#define REP_FFNOUT 1
#endif
#ifndef REP_NORM
#define REP_NORM 1
#endif
#ifndef REP_FOXPROJ
#define REP_FOXPROJ 1
#endif
#ifndef REP_RETPROJ
#define REP_RETPROJ 1
#endif
struct Args { Ptrs P; int ph_lo, ph_hi, li, pad; };
constexpr int N_PHASES = 1 + 8 * 2 + 2 * 4 + 2 * 5 + 1 + 2 * 3 * (REP_RET - 1);
#ifndef PHMASK
#define PHMASK 0xffffffffu
#endif
#define EN(k) ((PHMASK >> (k)) & 1u)
#ifndef STAGGER
#define STAGGER 0
#endif
#define STAGGER_WAIT() do { if (STAGGER && (bxl & 1)) { _Pragma("unroll") for (int q_ = 0; q_ < STAGGER; ++q_) __builtin_amdgcn_s_sleep(127); } } while (0)
#ifndef FOX_PRUNE
#define FOX_PRUNE 0
#endif

__global__ void __launch_bounds__(NWAVES * 64, 2) mega_fwd(Args args) {
    extern __shared__ __attribute__((aligned(16))) unsigned char lds_raw[];
    LAS unsigned char* lds = (LAS unsigned char*)lds_raw;
    typedef const __attribute__((address_space(4))) Args* KArgs;
    const KArgs kap = (KArgs)__builtin_amdgcn_kernarg_segment_ptr();
    const int G = gridDim.x, bx = blockIdx.x;
    const int vcu = (G % 8 == 0) ? (bx % 8) * (G / 8) + bx / 8 : bx;
    const int NGW = G * NWAVES;
    unsigned char* ws = kap->P.ws;
    gu32* ctl = (gu32*)(ws + WS_CTL);
    for (int u = threadIdx.x; u < (LDS_BYTES - LDSCTL_OFF) / 4; u += NWAVES * 64) ((LAS unsigned*)(lds + LDSCTL_OFF))[u] = 0u;
    __syncthreads();
    volatile LAS unsigned* MISC = (volatile LAS unsigned*)(lds + MISC_OFF);
    XcdBarrier bar = xcd_barrier_post((unsigned*)(ctl + CW_BAR) + kap->li * XCD_BAR_WORDS, MISC + 8);
    const int lo = kap->ph_lo, hi = kap->ph_hi;
    int pid = 0;
#define PHASE_BEGIN if (pid >= lo && pid < hi) { KArgs kp_ = kap; asm volatile("" : "+s"(kp_)); \
        const Ptrs P = {kp_->P.x_prompt, kp_->P.x_sample, kp_->P.cache_k, kp_->P.cache_v, kp_->P.cache_lf, kp_->P.state_ret, kp_->P.norm_gains, kp_->P.w_ffn_in, kp_->P.w_ffn_out, kp_->P.fox_w_in, kp_->P.fox_b_f, \
                        kp_->P.fox_qg, kp_->P.fox_kg, kp_->P.fox_w_out, kp_->P.ret_w_in, kp_->P.ret_w_out, kp_->P.final_gain, kp_->P.out, kp_->P.ws}; (void)P; \
        unsigned char* ws = P.ws; gu32* ctl = (gu32*)(ws + WS_CTL); bf16* X = (bf16*)(ws + WS_X); float* SSQP = (float*)(ws + WS_SSQP); float* SSQS = (float*)(ws + WS_SSQS); (void)ctl; (void)X; (void)SSQP; (void)SSQS; \
        int tid = threadIdx.x; asm volatile("" : "+v"(tid)); const int lane = tid & 63, wave = __builtin_amdgcn_readfirstlane(tid >> 6), gw = vcu * NWAVES + wave; (void)lane; (void)gw; int bxl = blockIdx.x; asm volatile("" : "+s"(bxl)); (void)bxl;
#define PHASE_END   if (pid + 1 < hi) xcd_barrier(bar); } ++pid;

    bf16* X = (bf16*)(ws + WS_X); bf16* XN = (bf16*)(ws + WS_XN);
    float* SSQP = (float*)(ws + WS_SSQP); float* SSQS = (float*)(ws + WS_SSQS);
    LAS float* rsb = (LAS float*)(lds + RSB_OFF);

#define SAMPLE_WIDE(EpiT, nb_, woff_, ...) do { unsigned char* ws2 = P.ws; asm volatile("" : "+s"(ws2));     \
        LAS float* rsl_ = (LAS float*)(lds + RSB_OFF) + 13 * 256; const EpiT E2_ = __VA_ARGS__; \
        const bool g256_ = (G == 256); const int t_ = (bxl & 7) * (nb_) + (bxl >> 3); \
        int L_ = g256_ ? (((bxl >> 3) < (nb_)) ? (t_ & 7) + 8 * (t_ >> 3) : 8 * (nb_)) : vcu; const int st_ = g256_ ? 8 * (nb_) : G; \
        for (; L_ < 8 * (nb_); L_ += st_) pg8::sample_wide_unit<EpiT>(lds + RING_OFF, rsl_, (const bf16*)(ws2 + WS_X), (const bf16*)(ws2 + (woff_)), (const float*)(ws2 + WS_SSQS), L_, E2_); } while (0)

    PHASE_BEGIN if (EN(0)) for (int rep = 0; rep < REP_P0; ++rep) { p0_prologue(P, lds, gw, NGW, wave, lane); if (rep + 1 < REP_P0) xcd_barrier(bar); } PHASE_END

    for (int s = 0; s < 8; ++s) {
        const int layer = s >> 1, half = s & 1, jl = layer >> 1;
        PHASE_BEGIN if (EN(2)) for (int rep = 0; rep < REP_FFNIN; ++rep) {
            if (rep) xcd_barrier(bar);
            pg8::Gemm g{X, (const bf16*)(ws + WS_WFI + (size_t)s * WFI_STRIDE), MP, 2 * FF, DM}; pg8::StaticOrder S; S.init(MP, 2 * FF, G, bxl);
            const pg8::RstdHook<pg8::StaticOrder> RH{S, SSQP, SSQS, rsb};
            pg8::EpiSwiglu E{(bf16*)(ws + WS_ACT), FF, rsb};
            pg8::gemm_phase<pg8::EpiSwiglu, pg8::StaticOrder, true, true, DM, true, true, pg8::RstdHook<pg8::StaticOrder>>(lds + RING_OFF, g, S, E, RH);
            SAMPLE_WIDE(pg8::EpiSwiglu, 22, WS_WFI + (size_t)s * WFI_STRIDE, {(bf16*)(ws2 + WS_ACT), FF, nullptr});
        } PHASE_END
        PHASE_BEGIN if (EN(3)) {
            const bf16* wfo = (const bf16*)(ws + WS_WFO + (size_t)s * WFO_STRIDE);
            pg8::Gemm g{(const bf16*)(ws + WS_ACT), wfo, MP, DM, FF}; pg8::StaticOrder S; S.init(MP, DM, G, bxl);
            pg8::EpiResid E{X, 0.5f, SSQP};
            pg8::gemm_phase<pg8::EpiResid, pg8::StaticOrder, true, true, FF, true, true>(lds + RING_OFF, g, S, E);
            for (int L = vcu; L < 256; L += G) small_gemm_resid<true, true>((const bf16*)(ws + WS_ACT), wfo, FF, X, 0.5f, L, lds, SSQS);
        } PHASE_END
        if (half == 0) {
            if ((layer & 1) == 0) {
#define LOGF ((float*)(ws + WS_LOGF))
#define ND ((float*)(ws + WS_ND))
#define Qb ((bf16*)(ws + WS_Q))
#define Kb ((bf16*)(ws + WS_K))
#define Vb ((bf16*)(ws + WS_V))
#define OGb ((bf16*)(ws + WS_OG))
#define AOb ((bf16*)(ws + WS_AO))
                PHASE_BEGIN if (EN(4)) forget_phase(X, P.norm_gains + (size_t)layer * 3 * DM + DM, (const float*)(ws + WS_WF) + (size_t)jl * 16 * 1024, P.fox_b_f + jl * 16, LOGF,
                                             P.out + O_FLP + (size_t)jl * MP * 16, P.out + O_FLS + (size_t)jl * MS * 16, lds, gw, NGW, tid, lane); PHASE_END
                PHASE_BEGIN if (EN(5)) for (int rep = 0; rep < REP_FOXPROJ; ++rep) {
                    if (rep) xcd_barrier(bar);
                    if (bxl >= G - 32) {
                        const float mq = wave_max(fabsf(P.fox_qg[jl * 64 + lane]), lane), mk = wave_max(fabsf(P.fox_kg[jl * 64 + lane]), lane);
                        cumsum_unit(LOGF, ND, bxl - (G - 32), lds, tid, wave, lane, FOX_PRUNE_T + 2.f * (8.f * mq * mk * LOG2E), (int*)(ws + WS_T0)); }
                    if (tid < 128) ((LAS float*)(lds + GL_OFF))[tid] = (tid < 64) ? P.fox_qg[jl * 64 + tid] : P.fox_kg[jl * 64 + tid - 64];
                    __syncthreads();
                    pg8::Gemm g{X, (const bf16*)(ws + WS_WXI + (size_t)jl * WXI_STRIDE), MP, 4096, DM}; pg8::StaticOrder S; S.init(MP, 4096, G, bxl);
                    const pg8::RstdHook<pg8::StaticOrder> RH{S, SSQP, SSQS, rsb};
                    pg8::EpiFoxProj E{Qb, Kb, Vb, OGb, nullptr, nullptr, nullptr, nullptr,
                                      (const LAS float*)(lds + GL_OFF), rsb, attn_body::C2};
                    pg8::gemm_phase<pg8::EpiFoxProj, pg8::StaticOrder, true, true, DM, true, true, pg8::RstdHook<pg8::StaticOrder>>(lds + RING_OFF, g, S, E, RH);
                    SAMPLE_WIDE(pg8::EpiFoxProj, 16, WS_WXI + (size_t)jl * WXI_STRIDE, {(bf16*)(ws2 + WS_Q), (bf16*)(ws2 + WS_K), (bf16*)(ws2 + WS_V), (bf16*)(ws2 + WS_OG), nullptr, nullptr, nullptr, nullptr, (const LAS float*)(lds + GL_OFF), nullptr, attn_body::C2});
                } PHASE_END
                PHASE_BEGIN if (EN(6)) {
                    for (int rep = 0; rep < REP_ATTN; ++rep) {
                    if (rep) xcd_barrier(bar);
                    gu32* tkt = ctl + 1024 + 64 * jl + 128 * rep;
                    ((LAS v4u*)(lds + RSB_OFF))[tid] = ((const v4u*)(ws + WS_T0))[tid]; __syncthreads();
                    unsigned nk = 0u;
                    { int tq_ = threadIdx.x; asm volatile("" : "+v"(tq_)); gu32* tk2 = tkt; asm volatile("" : "+s"(tk2)); if (tq_ == 0) { nk = __hip_atomic_fetch_add(tk2, 1u, __ATOMIC_RELAXED, __HIP_MEMORY_SCOPE_AGENT); MISC[17] = nk; } }
                    for (;;) {
                        int tq_ = threadIdx.x; asm volatile("" : "+v"(tq_));
                        __syncthreads();
                        const int k = (int)MISC[17];
                        __syncthreads();
                        if (k >= 2560) break;
                        { gu32* tk2 = tkt; asm volatile("" : "+s"(tk2)); if (tq_ == 0) nk = __hip_atomic_fetch_add(tk2, 1u, __ATOMIC_RELAXED, __HIP_MEMORY_SCOPE_AGENT); }
                        const int kq = k / 10, kr = k - 10 * kq;
                        if (kr == 8) { if (EN(7)) smp::unit(jl, kq >> 4, kq & 15, P.cache_k, P.cache_v, P.cache_lf, LOGF, Qb, Kb, Vb, OGb, AOb, lds + RING_OFF); if (tq_ == 0) MISC[17] = nk; continue; }
                        if (kr == 9) { kv_out_chunk(Kb, Vb, P.out + O_FKP + (size_t)jl * MP * DM, P.out + O_FVP + (size_t)jl * MP * DM, P.out + O_FKS + (size_t)jl * MS * DM, P.out + O_FVS + (size_t)jl * MS * DM, kq); if (tq_ == 0) MISC[17] = nk; continue; }
                        const int u = kq * 8 + kr, bh = u & 31, qb = 63 - (u >> 5);
                        const int t0 = FOX_PRUNE ? __builtin_amdgcn_readfirstlane(((const LAS int*)(lds + RSB_OFF))[bh * 64 + qb]) : 0;
                        attn_body::attn_unit<8>(bh >> 4, bh & 15, qb, t0, (const attn_body::bf16*)Qb, (const attn_body::bf16*)Kb, (const attn_body::bf16*)Vb, (const attn_body::bf16*)OGb, ND,
                                                (attn_body::bf16*)AOb, (char*)lds_raw + RING_OFF, nk, MISC + 17);
                    }
                    }
                } PHASE_END
                PHASE_BEGIN if (EN(8)) {
                    const bf16* wxo = (const bf16*)(ws + WS_WXO + (size_t)jl * WXO_STRIDE);
                    pg8::Gemm g{AOb, wxo, MP, DM, DM}; pg8::StaticOrder S; S.init(MP, DM, G, bxl);
                    pg8::EpiResid E{X, 1.0f, SSQP};
                    pg8::gemm_phase<pg8::EpiResid, pg8::StaticOrder, true, true, DM, false, true>(lds + RING_OFF, g, S, E);
                    for (int L = vcu; L < 256; L += G) small_gemm_resid<false, true>(AOb, wxo, DM, X, 1.0f, L, lds, SSQS);
                } PHASE_END
            } else {
#define RQ ((bf16*)(ws + WS_RQ))
#define RK ((bf16*)(ws + WS_RK))
#define RV ((bf16*)(ws + WS_RV))
#define RG ((bf16*)(ws + WS_RG))
#define RO ((bf16*)(ws + WS_RO))
#define U ((float*)(ws + WS_U))
                PHASE_BEGIN if (EN(10)) for (int rep = 0; rep < REP_RETPROJ; ++rep) {
                    if (rep) xcd_barrier(bar);
                    pg8::Gemm g{X, (const bf16*)(ws + WS_WRI + (size_t)jl * WRI_STRIDE), MP, 6144, DM}; pg8::StaticOrder S; S.init(MP, 6144, G, bxl);
                    const pg8::RstdHook<pg8::StaticOrder> RH{S, SSQP, SSQS, rsb};
                    pg8::EpiRetProj E{RQ, RK, RV, RG, rsb};
                    pg8::gemm_phase<pg8::EpiRetProj, pg8::StaticOrder, true, true, DM, true, true, pg8::RstdHook<pg8::StaticOrder>>(lds + RING_OFF, g, S, E, RH);
                    SAMPLE_WIDE(pg8::EpiRetProj, 24, WS_WRI + (size_t)jl * WRI_STRIDE, {(bf16*)(ws2 + WS_RQ), (bf16*)(ws2 + WS_RK), (bf16*)(ws2 + WS_RV), (bf16*)(ws2 + WS_RG), nullptr});
                } PHASE_END
                for (int rrep = 0; rrep < REP_RET; ++rrep) {
                PHASE_BEGIN if (EN(11)) {
                    for (int L = vcu; L < 256; L += G) { const int bh = L >> 4, sc = L & 15, b = bh >> 3, h = bh & 7;
                        ret::unit<false>(lds + RING_OFF, b * SEQ + sc * (ret::GCH * 64), ret::GCH, 64, h, ret_lg2(h), RQ, RK, RV, RG, RO, nullptr, U + (size_t)(bh * 16 + sc) * 32768); }
                } PHASE_END
                PHASE_BEGIN if (EN(12)) ret_scan_phase(U, P.out + O_RP + (size_t)jl * 16 * 32768, gw * 64 + lane, NGW * 64); PHASE_END
                PHASE_BEGIN if (EN(13)) {
                    for (int L = vcu; L < 256; L += G) { const int bh = L >> 4, sc = L & 15, b = bh >> 3, h = bh & 7;
                        ret::unit<true>(lds + RING_OFF, b * SEQ + sc * (ret::GCH * 64), ret::GCH, 64, h, ret_lg2(h), RQ, RK, RV, RG, RO, U + (size_t)(bh * 16 + sc) * 32768, nullptr); }
                    for (int L = vcu; L < 128; L += G) { const int b = L >> 3, h = L & 7;
                        ret::unit<true>(lds + RING_OFF, MP + b * DEC_S, 1, DEC_S, h, ret_lg2(h), RQ, RK, RV, RG, RO, P.state_ret + ((size_t)(jl * DEC_B + b) * 8 + h) * 32768,
                                        P.out + O_RS + ((size_t)(jl * DEC_B + b) * 8 + h) * 32768); }
                } PHASE_END
                }
                PHASE_BEGIN if (EN(15)) {
                    const bf16* wro = (const bf16*)(ws + WS_WRO + (size_t)jl * WRO_STRIDE);
                    pg8::Gemm g{RO, wro, MP, DM, 2048}; pg8::StaticOrder S; S.init(MP, DM, G, bxl);
                    pg8::EpiResid E{X, 1.0f, SSQP};
                    pg8::gemm_phase<pg8::EpiResid, pg8::StaticOrder, true, true, 2048, true, true>(lds + RING_OFF, g, S, E);
                    for (int L = vcu; L < 256; L += G) small_gemm_resid<true, true>(RO, wro, 2048, X, 1.0f, L, lds, SSQS);
                } PHASE_END
            }
        }
    }
    PHASE_BEGIN if (EN(16)) final_norm_phase(X, P.final_gain, P.out + O_YP, P.out + O_YS, gw, NGW, lane); PHASE_END
#undef PHASE_BEGIN
#undef PHASE_END
}

#ifndef MK_N_LAUNCHES
#define MK_N_LAUNCHES 1
#endif
#undef LOGF
#undef ND
#undef Qb
#undef Kb
#undef Vb
#undef OGb
#undef AOb
#undef RQ
#undef RK
#undef RV
#undef RG
#undef RO
#undef U
extern "C" void kernel_launch(void* const* d_in, const int* in_sizes, int n_in, void* d_out, int out_size, void* d_ws, size_t ws_size, hipStream_t stream) {
    static int grid = 0;
    if (grid == 0) {
        if (n_in != 17 || (size_t)out_size != O_END || ws_size < WS_END) { fprintf(stderr, "kernel_launch: built for 17 inputs, %zu outputs, >= %zu bytes of workspace; got n_in %d, out %d, ws %zu; nothing launched\n", (size_t)O_END, (size_t)WS_END, n_in, out_size, ws_size); grid = -1; return; }
        int dev = 0, cus = 0, per_cu = 0;
        if (hipGetDevice(&dev) != hipSuccess || hipDeviceGetAttribute(&cus, hipDeviceAttributeMultiprocessorCount, dev) != hipSuccess) { fprintf(stderr, "kernel_launch: device query failed\n"); grid = -1; return; }
        if (hipFuncSetAttribute((const void*)mega_fwd, hipFuncAttributeMaxDynamicSharedMemorySize, LDS_BYTES) != hipSuccess) { fprintf(stderr, "kernel_launch: hipFuncSetAttribute failed\n"); grid = -1; return; }
        if (hipOccupancyMaxActiveBlocksPerMultiprocessor(&per_cu, (const void*)mega_fwd, NWAVES * 64, LDS_BYTES) != hipSuccess || per_cu < 1)
            fprintf(stderr, "kernel_launch: note: occupancy query reports %d workgroups per CU\n", per_cu);
        (void)hipGetLastError();
        grid = cus;
    }
    if (grid < 0) return;
    if (hipMemsetAsync((char*)d_ws + WS_CTL, 0, CTL_ZERO_BYTES, stream) != hipSuccess) { fprintf(stderr, "kernel_launch: memset failed\n"); return; }
    Args a{};
    const float** pp = (const float**)&a.P;
    for (int i = 0; i < 17; ++i) pp[i] = (const float*)d_in[i];
    a.P.out = (float*)d_out; a.P.ws = (unsigned char*)d_ws;
    const int NL = MK_N_LAUNCHES;
    for (int li = 0; li < NL; ++li) {
        a.ph_lo = (int)((long)N_PHASES * li / NL); a.ph_hi = (int)((long)N_PHASES * (li + 1) / NL); a.li = li; a.pad = 0;
        hipLaunchKernelGGL(mega_fwd, dim3(grid), dim3(NWAVES * 64), LDS_BYTES, stream, a);
        const hipError_t le = hipPeekAtLastError();
        if (le != hipSuccess) { fprintf(stderr, "kernel_launch: launch %d failed: %s\n", li, hipGetErrorName(le)); break; }
    }
}
```

```cpp
#include <hip/hip_runtime.h>
#include <hip/hip_bf16.h>
#include <cstdio>
#include <cstdint>
#include <cmath>
#define FOX_PRUNE 1
#define FOX_PRUNE_T 40.f
#ifndef EPI_SEL
#define EPI_SEL 0
#endif
namespace pg8 {
#define PG8_LAS __attribute__((address_space(3)))
typedef unsigned short bf16_t;
typedef short bf16x8 __attribute__((ext_vector_type(8)));
typedef float f32x4 __attribute__((ext_vector_type(4)));
typedef unsigned u32x4 __attribute__((ext_vector_type(4)));
constexpr int BM = 256, BK = 64, HALF = 128, HTB = HALF * BK * 2  , STAGE_BYTES = 8 * HTB, NXCD = 8, WGM = 8;

__host__ __device__ __forceinline__ int lds_byte(int r, int c) { const int st = (r >> 4) * 2 + (c >> 5), rr = r & 15, cc = c & 31, ob = rr * 64 + cc * 2; return st * 1024 + (ob ^ (((ob >> 9) & 1) << 5)); }
__host__ __device__ __forceinline__ void stage_rc(int b, int& R, int& C) { const int st = b / 1024, sb = b % 1024, swz = sb ^ (((sb >> 9) & 1) << 5); R = (st >> 1) * 16 + swz / 64; C = (st & 1) * 32 + (swz % 64) / 2; }
__host__ __device__ __forceinline__ int perm32(int rho) { const int n = rho >> 4, i = rho & 15; return 8 * (i >> 2) + 4 * n + (i & 3); }

__host__ __device__ __forceinline__ int perm32inv(int x) { return 16 * ((x >> 2) & 1) + 4 * (x >> 3) + (x & 3); }
__host__ __device__ __forceinline__ size_t pk_elem(int row, int k, int nt) { return ((size_t)((row >> 8) * nt + (k >> 6)) * 2 + ((row >> 7) & 1)) * (size_t)(HTB / 2) + (size_t)(lds_byte(row & 127, k & 63) >> 1); }
__host__ __device__ __forceinline__ int pk_slot(int n) { return (n & ~31) + perm32inv(n & 31); }

struct Unit { int pm, pn, ord; };
struct Gemm { const bf16_t* A; const bf16_t* Bt; int M, N, K; };

struct StaticOrder {
    int nM, nN, nwg, G, c;
    __host__ __device__ void init(int M, int N, int G_, int c_) { nM = M / BM; nN = N / BM; nwg = nM * nN; G = G_; c = c_; }
    __host__ __device__ bool next(int i, Unit& u) const {
        const long L = (long)i * G + c; if (L >= nwg) return false;
        int wgid = (int)L; { const int q = nwg / NXCD, r = nwg % NXCD, xcd = wgid % NXCD, off = wgid / NXCD; wgid = (xcd < r ? xcd * (q + 1) : r * (q + 1) + (xcd - r) * q) + off; }
        const int nig = WGM * nN, gid = wgid / nig, fm = gid * WGM, gsz = (nM - fm) < WGM ? (nM - fm) : WGM;
        u.pm = fm + ((wgid % nig) % gsz); u.pn = (wgid % nig) / gsz; u.ord = i; return true;
    }
    __device__ __forceinline__ void a_ready(const Unit&) const {}
    __device__ __forceinline__ void done(const Unit&) const {}
};

__device__ __forceinline__ unsigned cvt_pk_bf16(float lo, float hi) { unsigned r; asm volatile("v_cvt_pk_bf16_f32 %0, %1, %2" : "=v"(r) : "v"(lo), "v"(hi)); return r; }
typedef float f32x2 __attribute__((ext_vector_type(2)));
constexpr int EP_MP = 32768;
__device__ __forceinline__ unsigned pk_bf16(float lo, float hi) { typedef float f2 __attribute__((ext_vector_type(2))); typedef __bf16 b2 __attribute__((ext_vector_type(2))); f2 v = {lo, hi}; b2 b = __builtin_convertvector(v, b2); return __builtin_bit_cast(unsigned, b); }
__device__ __forceinline__ u32x4 pk8(const f32x4 a, const f32x4 b) { u32x4 w; w.x = pk_bf16(a[0], a[1]); w.y = pk_bf16(a[2], a[3]); w.z = pk_bf16(b[0], b[1]); w.w = pk_bf16(b[2], b[3]); return w; }
__device__ __forceinline__ float sigmoidf_fast(float x) { return __builtin_amdgcn_rcpf(1.0f + __builtin_amdgcn_exp2f(-1.4426950408889634f * x)); }

constexpr int RSB_MAX_UNITS = 14;
template <class Sched>
__device__ __forceinline__ void rstd_prologue(const Sched& S, const float* SSQP, const float* SSQS, PG8_LAS float* rsb, int tid) {
    const int r = tid >> 1, hf = tid & 1, lane = tid & 63;
    f32x4 pa[RSB_MAX_UNITS], pb[RSB_MAX_UNITS]; int kind[RSB_MAX_UNITS];
#pragma unroll
    for (int i = 0; i < RSB_MAX_UNITS; ++i) { Unit u; kind[i] = 0; pa[i] = (f32x4){0.f, 0.f, 0.f, 0.f}; pb[i] = pa[i];
        if (S.next(i, u)) { const int row = u.pm * BM + r;
            if (row < EP_MP) { const float* q = SSQP + (size_t)row * 16 + 8 * hf; pa[i] = *(const f32x4*)q; pb[i] = *(const f32x4*)(q + 4); kind[i] = 1; } else kind[i] = 2 + (u.pm - EP_MP / BM); } }
#pragma unroll
    for (int i = 0; i < RSB_MAX_UNITS; ++i) {
        if (kind[i] == 0) continue;
        float s = ((pa[i][0] + pa[i][1]) + (pa[i][2] + pa[i][3])) + ((pb[i][0] + pb[i][1]) + (pb[i][2] + pb[i][3]));
        if (kind[i] >= 2) { const float* q = SSQS + (size_t)((kind[i] - 2) * BM + r) * 64 + 32 * hf; s = 0.f;
#pragma unroll
            for (int k = 0; k < 8; ++k) { const f32x4 a = *(const f32x4*)(q + 4 * k); s += (a[0] + a[1]) + (a[2] + a[3]); } }
        s += __int_as_float(__builtin_amdgcn_ds_bpermute((lane ^ 1) << 2, __float_as_int(s)));
        if (hf == 0) rsb[i * 256 + r] = __builtin_amdgcn_rsqf(s * (1.0f / 1024.0f) + 1e-6f);
    }
    __syncthreads();
}
template <class Sched>
struct RstdHook { const Sched& S; const float* SSQP; const float* SSQS; PG8_LAS float* rsb;
    __device__ __forceinline__ void operator()(int tid) const { rstd_prologue(S, SSQP, SSQS, rsb, tid); } };
__device__ __forceinline__ void rows_rstd(float (&rs)[2][4], const PG8_LAS float* rsb, const Unit& u, int wr, int fr) {
#pragma unroll
    for (int ai = 0; ai < 2; ++ai)
#pragma unroll
        for (int m = 0; m < 4; ++m) rs[ai][m] = rsb[u.ord * 256 + ai * HALF + wr * 64 + m * 16 + fr];
}
struct EpiSwiglu {
    static constexpr bool PERM = true, AFTER_DRAIN = false, INIT = false, IDEMP = (EPI_SEL == 0);
    bf16_t* O; int ldc; const PG8_LAS float* rsb;
    __device__ __forceinline__ void operator()(const f32x4 (&acc)[2][2][4][2], const Unit& u, int wr, int wc, int fr, int fq) const {
        const int row0 = u.pm * BM + wr * 64 + fr, col0 = u.pn * 128 + wc * 32 + 8 * fq;
        float rsa[2][4]; rows_rstd(rsa, rsb, u, wr, fr);
#pragma unroll
        for (int ai = 0; ai < 2; ++ai)
#pragma unroll
            for (int m = 0; m < 4; ++m) {
                f32x4 h[2]; const float rs = rsa[ai][m], c1 = -1.4426950408889634f * rs, rs2 = rs * rs;
#pragma unroll
                for (int n = 0; n < 2; ++n) { const f32x4 g = acc[ai][0][m][n], uu = acc[ai][1][m][n]; const f32x4 t = g * c1; f32x4 d, r;
#pragma unroll
                    for (int e = 0; e < 4; ++e) d[e] = __builtin_amdgcn_exp2f(t[e]);
                    d = d + 1.0f;
#pragma unroll
                    for (int e = 0; e < 4; ++e) r[e] = __builtin_amdgcn_rcpf(d[e]);
                    h[n] = (g * uu) * (r * rs2); }
                *(u32x4*)(O + pk_elem(row0 + ai * HALF + m * 16, col0, ldc >> 6)) = pk8(h[0], h[1]);
            }
    }
    __device__ __forceinline__ void rowgrp(const f32x4 (&v)[2][2], int row, float rs, int pn, int wc, int fr, int fq) const {
        f32x4 h[2];
#pragma unroll
        for (int n = 0; n < 2; ++n) { const f32x4 g = v[0][n] * rs, uu = v[1][n] * rs;
#pragma unroll
            for (int e = 0; e < 4; ++e) h[n][e] = g[e] * uu[e] * sigmoidf_fast(g[e]); }
        *(u32x4*)(O + pk_elem(row, pn * 128 + wc * 32 + 8 * fq, ldc >> 6)) = pk8(h[0], h[1]);
    }
};
struct EpiResid {
    static constexpr bool PERM = true, AFTER_DRAIN = false, INIT = false, IDEMP = false;
    bf16_t* X; float s; float* SSQ;
    __device__ __forceinline__ void init(f32x4 (&acc)[2][2][4][2], const Unit& u, int wr, int wc, int fr, int fq) const {}
    __device__ __forceinline__ void operator()(const f32x4 (&acc)[2][2][4][2], const Unit& u, int wr, int wc, int fr, int fq) const {
        const int row0 = u.pm * BM + wr * 64 + fr;
        bf16_t* xb = X + pk_elem(row0, u.pn * BM + wc * 32 + 8 * fq, 16);
        u32x4 b[2][4][2];
#pragma unroll
        for (int ai = 0; ai < 2; ++ai)
#pragma unroll
            for (int m = 0; m < 4; ++m)
#pragma unroll
                for (int bj = 0; bj < 2; ++bj) b[ai][m][bj] = *(const u32x4*)(xb + 8192 * ai + 1024 * m + 32768 * bj);
#pragma unroll
        for (int ai = 0; ai < 2; ++ai) {
#pragma unroll
            for (int m = 0; m < 4; ++m) { float ss = 0.f;
#pragma unroll
                for (int bj = 0; bj < 2; ++bj) { const u32x4 w = b[ai][m][bj]; const f32x4 a0 = acc[ai][bj][m][0] * s, a1 = acc[ai][bj][m][1] * s;
                    const f32x4 v0 = {__uint_as_float(w.x << 16) + a0[0], __uint_as_float(w.x & 0xffff0000u) + a0[1], __uint_as_float(w.y << 16) + a0[2], __uint_as_float(w.y & 0xffff0000u) + a0[3]};
                    const f32x4 v1 = {__uint_as_float(w.z << 16) + a1[0], __uint_as_float(w.z & 0xffff0000u) + a1[1], __uint_as_float(w.w << 16) + a1[2], __uint_as_float(w.w & 0xffff0000u) + a1[3]};
                    ss += ((v0[0] * v0[0] + v0[1] * v0[1]) + (v0[2] * v0[2] + v0[3] * v0[3])) + ((v1[0] * v1[0] + v1[1] * v1[1]) + (v1[2] * v1[2] + v1[3] * v1[3]));
                    *(u32x4*)(xb + 8192 * ai + 1024 * m + 32768 * bj) = pk8(v0, v1); }
                ss += __int_as_float(__builtin_amdgcn_ds_bpermute((fr + 16 * (fq ^ 1)) << 2, __float_as_int(ss)));
                ss += __int_as_float(__builtin_amdgcn_ds_bpermute((fr + 16 * (fq ^ 2)) << 2, __float_as_int(ss)));
                if (fq == 0) SSQ[(size_t)(row0 + ai * HALF + m * 16) * 16 + 4 * u.pn + wc] = ss; }
        }
    }
};
struct EpiFoxProj {
    static constexpr bool PERM = true, AFTER_DRAIN = false, INIT = false, IDEMP = (EPI_SEL == 1);
    bf16_t *Q, *K, *V, *OG;
    float *kP, *vP, *kS, *vS;
    const PG8_LAS float* gl;
    const PG8_LAS float* rsb;
    float qscale;
    template <int KIND  >
    __device__ __forceinline__ void rows(const f32x4 (&acc)[2][2][4][2], const f32x4 (&gn)[2][2], const float (&rsa)[2][4], int row0, int colh, int fr, int fq) const {
        bf16_t* dstb = (KIND == 0) ? Q : (KIND == 1) ? K : (KIND == 2) ? V : OG;
#pragma unroll
        for (int ai = 0; ai < 2; ++ai)
#pragma unroll
            for (int m = 0; m < 4; ++m) {
                const int row = row0 + ai * HALF + m * 16;
                f32x4 v[2][2];
#pragma unroll
                for (int bj = 0; bj < 2; ++bj)
#pragma unroll
                    for (int n = 0; n < 2; ++n) v[bj][n] = acc[ai][bj][m][n] * rsa[ai][m];
                if (KIND <= 1) {
                    float ss = 0.f;
#pragma unroll
                    for (int bj = 0; bj < 2; ++bj)
#pragma unroll
                        for (int n = 0; n < 2; ++n) { const f32x4 x = v[bj][n]; ss += (x[0] * x[0] + x[1] * x[1]) + (x[2] * x[2] + x[3] * x[3]); }
                    ss += __int_as_float(__builtin_amdgcn_ds_bpermute((fr + 16 * (fq ^ 1)) << 2, __float_as_int(ss))); ss += __int_as_float(__builtin_amdgcn_ds_bpermute((fr + 16 * (fq ^ 2)) << 2, __float_as_int(ss)));
                    float rinv = __builtin_amdgcn_rsqf(ss * (1.0f / 64.0f) + 1e-6f); if (KIND == 0) rinv *= qscale;
#pragma unroll
                    for (int bj = 0; bj < 2; ++bj)
#pragma unroll
                        for (int n = 0; n < 2; ++n) v[bj][n] = v[bj][n] * rinv * gn[bj][n];
                } else if (KIND == 3) {
#pragma unroll
                    for (int bj = 0; bj < 2; ++bj)
#pragma unroll
                        for (int n = 0; n < 2; ++n)
#pragma unroll
                            for (int e = 0; e < 4; ++e) v[bj][n][e] = sigmoidf_fast(v[bj][n][e]);
                }
                bf16_t* rp = dstb + (size_t)row * 1024 + colh;
#pragma unroll
                for (int bj = 0; bj < 2; ++bj) *(u32x4*)(rp + 32 * bj) = pk8(v[bj][0], v[bj][1]);
                if ((KIND == 1 || KIND == 2) && kP != nullptr) {
                    float* o = (row < EP_MP) ? ((KIND == 1 ? kP : vP) + (size_t)row * 1024) : ((KIND == 1 ? kS : vS) + (size_t)(row - EP_MP) * 1024);
                    o += colh;
#pragma unroll
                    for (int bj = 0; bj < 2; ++bj)
#pragma unroll
                        for (int n = 0; n < 2; ++n) *(f32x4*)(o + 32 * bj + 4 * n) = v[bj][n];
                }
            }
    }
    template <int KIND>
    __device__ __forceinline__ void rowgrp1(const f32x4 (&a)[2][2], const f32x4 (&gn)[2][2], float rs, int row, int colh, int fr, int fq) const {
        bf16_t* dstb = (KIND == 0) ? Q : (KIND == 1) ? K : (KIND == 2) ? V : OG;
        f32x4 v[2][2];
#pragma unroll
        for (int bj = 0; bj < 2; ++bj)
#pragma unroll
            for (int n = 0; n < 2; ++n) v[bj][n] = a[bj][n] * rs;
        if (KIND <= 1) {
            float ss = 0.f;
#pragma unroll
            for (int bj = 0; bj < 2; ++bj)
#pragma unroll
                for (int n = 0; n < 2; ++n) { const f32x4 x = v[bj][n]; ss += (x[0] * x[0] + x[1] * x[1]) + (x[2] * x[2] + x[3] * x[3]); }
            ss += __int_as_float(__builtin_amdgcn_ds_bpermute((fr + 16 * (fq ^ 1)) << 2, __float_as_int(ss))); ss += __int_as_float(__builtin_amdgcn_ds_bpermute((fr + 16 * (fq ^ 2)) << 2, __float_as_int(ss)));
            float rinv = __builtin_amdgcn_rsqf(ss * (1.0f / 64.0f) + 1e-6f); if (KIND == 0) rinv *= qscale;
#pragma unroll
            for (int bj = 0; bj < 2; ++bj)
#pragma unroll
                for (int n = 0; n < 2; ++n) v[bj][n] = v[bj][n] * rinv * gn[bj][n];
        } else if (KIND == 3) {
#pragma unroll
            for (int bj = 0; bj < 2; ++bj)
#pragma unroll
                for (int n = 0; n < 2; ++n)
#pragma unroll
                    for (int e = 0; e < 4; ++e) v[bj][n][e] = sigmoidf_fast(v[bj][n][e]);
        }
        bf16_t* rp = dstb + (size_t)row * 1024 + colh;
#pragma unroll
        for (int bj = 0; bj < 2; ++bj) *(u32x4*)(rp + 32 * bj) = pk8(v[bj][0], v[bj][1]);
    }
    __device__ __forceinline__ void rowgrp(const f32x4 (&v)[2][2], int row, float rs, int pn, int wc, int fr, int fq) const {
        const int seg = pn >> 2, head = 4 * (pn & 3) + wc, colh = head * 64 + 8 * fq;
        f32x4 gn[2][2];
        const PG8_LAS float* gp = gl + ((seg == 1) ? 64 : 0);
#pragma unroll
        for (int bj = 0; bj < 2; ++bj)
#pragma unroll
            for (int n = 0; n < 2; ++n) gn[bj][n] = *(const PG8_LAS f32x4*)(gp + 32 * bj + 8 * fq + 4 * n);
        if (seg == 0) rowgrp1<0>(v, gn, rs, row, colh, fr, fq);
        else if (seg == 1) rowgrp1<1>(v, gn, rs, row, colh, fr, fq);
        else if (seg == 2) rowgrp1<2>(v, gn, rs, row, colh, fr, fq);
        else rowgrp1<3>(v, gn, rs, row, colh, fr, fq);
    }
    __device__ __forceinline__ void operator()(const f32x4 (&acc)[2][2][4][2], const Unit& u, int wr, int wc, int fr, int fq) const {
        const int seg = u.pn >> 2, head = 4 * (u.pn & 3) + wc;
        const int row0 = u.pm * BM + wr * 64 + fr, colh = head * 64 + 8 * fq;
        f32x4 gn[2][2];
        const PG8_LAS float* gp = gl + ((seg == 1) ? 64 : 0);
#pragma unroll
        for (int bj = 0; bj < 2; ++bj)
#pragma unroll
            for (int n = 0; n < 2; ++n) gn[bj][n] = *(const PG8_LAS f32x4*)(gp + 32 * bj + 8 * fq + 4 * n);
        float rsa[2][4]; rows_rstd(rsa, rsb, u, wr, fr);
        if (seg == 0) rows<0>(acc, gn, rsa, row0, colh, fr, fq);
        else if (seg == 1) rows<1>(acc, gn, rsa, row0, colh, fr, fq);
        else if (seg == 2) rows<2>(acc, gn, rsa, row0, colh, fr, fq);
        else rows<3>(acc, gn, rsa, row0, colh, fr, fq);
    }
};
struct EpiRetProj {
    static constexpr bool PERM = true, AFTER_DRAIN = false, INIT = false, IDEMP = (EPI_SEL == 2);
    bf16_t *RQ, *RK, *RV, *RG;
    const PG8_LAS float* rsb;
    __device__ __forceinline__ void operator()(const f32x4 (&acc)[2][2][4][2], const Unit& u, int wr, int wc, int fr, int fq) const {
        const int pn = u.pn, row0 = u.pm * BM + wr * 64 + fr;
        float rsa[2][4]; rows_rstd(rsa, rsb, u, wr, fr);
        if (pn < 8) {
            const int seg = pn >> 2, head = 2 * (pn & 3) + (wc >> 1), j0 = 32 * (wc & 1) + 8 * fq;
            float invf[2][4];
#pragma unroll
            for (int n = 0; n < 2; ++n)
#pragma unroll
                for (int e = 0; e < 4; ++e) invf[n][e] = __builtin_amdgcn_exp2f(-(float)(j0 + 4 * n + e) * (13.287712379549449f / 63.0f));
            const float ksc = (seg == 1) ? 0.08838834764831845f : 1.0f;
            bf16_t* dst = (seg == 0 ? RQ : RK);
#pragma unroll
            for (int ai = 0; ai < 2; ++ai)
#pragma unroll
                for (int m = 0; m < 4; ++m) {
                    const int row = row0 + ai * HALF + m * 16;
                    const float pos = (float)((row < EP_MP) ? (row & 16383) : (2048 + ((row - EP_MP) & 31)));
                    f32x4 o1[2], o2[2];
#pragma unroll
                    for (int n = 0; n < 2; ++n)
#pragma unroll
                        for (int e = 0; e < 4; ++e) {
                            const float ang = pos * invf[n][e];
                            const float nr = __builtin_rintf(ang * 0.15915493667125702f);
                            const float rev = __builtin_fmaf(ang, 0.15915493667125702f, -nr) + ang * 6.4206382432985265e-09f;
                            const float sn = __builtin_amdgcn_sinf(rev), cs = __builtin_amdgcn_cosf(rev);
                            const float x1 = acc[ai][0][m][n][e] * (ksc * rsa[ai][m]), x2 = acc[ai][1][m][n][e] * (ksc * rsa[ai][m]);
                            o1[n][e] = x1 * cs - x2 * sn; o2[n][e] = x1 * sn + x2 * cs;
                        }
                    bf16_t* rp = dst + (size_t)row * 1024 + head * 128 + j0;
                    *(u32x4*)(rp) = pk8(o1[0], o1[1]); *(u32x4*)(rp + 64) = pk8(o2[0], o2[1]);
                }
        } else {
            const bool isg = pn >= 16; bf16_t* dst = isg ? RG : RV;
            const int col0 = 256 * ((pn - 8) & 7) + wc * 32 + 8 * fq;
#pragma unroll
            for (int ai = 0; ai < 2; ++ai)
#pragma unroll
                for (int m = 0; m < 4; ++m) {
                    bf16_t* rp = dst + (size_t)(row0 + ai * HALF + m * 16) * 2048 + col0;
#pragma unroll
                    for (int bj = 0; bj < 2; ++bj) { f32x4 a = acc[ai][bj][m][0] * rsa[ai][m], b = acc[ai][bj][m][1] * rsa[ai][m];
                        if (isg) {
#pragma unroll
                            for (int e = 0; e < 4; ++e) { a[e] = a[e] * sigmoidf_fast(a[e]); b[e] = b[e] * sigmoidf_fast(b[e]); } }
                        *(u32x4*)(rp + bj * HALF) = pk8(a, b); }
                }
        }
    }
    __device__ __forceinline__ void rowgrp(const f32x4 (&v)[2][2], int row, float rs, int pn, int wc, int fr, int fq) const {
        if (pn < 8) {
            const int seg = pn >> 2, head = 2 * (pn & 3) + (wc >> 1), j0 = 32 * (wc & 1) + 8 * fq;
            const float ksc = ((seg == 1) ? 0.08838834764831845f : 1.0f) * rs;
            const float pos = (float)((row < EP_MP) ? (row & 16383) : (2048 + ((row - EP_MP) & 31)));
            f32x4 o1[2], o2[2];
#pragma unroll
            for (int n = 0; n < 2; ++n)
#pragma unroll
                for (int e = 0; e < 4; ++e) {
                    const float ang = pos * __builtin_amdgcn_exp2f(-(float)(j0 + 4 * n + e) * (13.287712379549449f / 63.0f));
                    const float nr = __builtin_rintf(ang * 0.15915493667125702f);
                    const float rev = __builtin_fmaf(ang, 0.15915493667125702f, -nr) + ang * 6.4206382432985265e-09f;
                    const float sn = __builtin_amdgcn_sinf(rev), cs = __builtin_amdgcn_cosf(rev);
                    const float x1 = v[0][n][e] * ksc, x2 = v[1][n][e] * ksc;
                    o1[n][e] = x1 * cs - x2 * sn; o2[n][e] = x1 * sn + x2 * cs;
                }
            bf16_t* rp = (seg == 0 ? RQ : RK) + (size_t)row * 1024 + head * 128 + j0;
            *(u32x4*)(rp) = pk8(o1[0], o1[1]); *(u32x4*)(rp + 64) = pk8(o2[0], o2[1]);
        } else {
            const bool isg = pn >= 16;
            bf16_t* rp = (isg ? RG : RV) + (size_t)row * 2048 + 256 * ((pn - 8) & 7) + wc * 32 + 8 * fq;
#pragma unroll
            for (int bj = 0; bj < 2; ++bj) { f32x4 a = v[bj][0] * rs, b = v[bj][1] * rs;
                if (isg) {
#pragma unroll
                    for (int e = 0; e < 4; ++e) { a[e] = a[e] * sigmoidf_fast(a[e]); b[e] = b[e] * sigmoidf_fast(b[e]); } }
                *(u32x4*)(rp + bj * HALF) = pk8(a, b); }
        }
    }
};
struct NoHook { __device__ __forceinline__ void operator()(int) const {} };
template <class Epi, class Sched, bool ALIGN_EPI = false, bool SP2 = false, int KC = 0, bool PKA = false, bool PKB = false, class Hook = NoHook>
__device__ __forceinline__ void gemm_phase(PG8_LAS unsigned char* lds, const Gemm g, const Sched& S, const Epi& E, const Hook& H = Hook()) {
    int tid_ = threadIdx.x; asm volatile("" : "+v"(tid_));
    const int tid = tid_, wid = __builtin_amdgcn_readfirstlane(tid >> 6), lane = tid & 63, wr = wid >> 2, wc = wid & 3, fr = lane & 15, fq = lane >> 4;
    const int K = KC ? KC : g.K, nt = K / BK;
    unsigned voffA[2], voffB[2];
#pragma unroll
    for (int i = 0; i < 2; ++i) { int R, C; stage_rc(tid * 16 + i * 8192, R, C); const int Rb = Epi::PERM ? ((R & ~31) + perm32(R & 31)) : R;
        voffA[i] = PKA ? (unsigned)(tid * 16 + i * 8192) : (unsigned)(R * K + C) * 2u; voffB[i] = PKB ? (unsigned)(tid * 16 + i * 8192) : (unsigned)(Rb * K + C) * 2u; }
    const size_t kstepA = PKA ? (size_t)(2 * HTB) : (size_t)(BK * 2), kstepB = PKB ? (size_t)(2 * HTB) : (size_t)(BK * 2);
    const size_t hstepA = PKA ? (size_t)HTB : (size_t)HALF * K * 2, hstepB = PKB ? (size_t)HTB : (size_t)HALF * K * 2;
    const size_t tstepA = PKA ? (size_t)nt * 2 * HTB : (size_t)BM * K * 2, tstepB = PKB ? (size_t)nt * 2 * HTB : (size_t)BM * K * 2;
    const unsigned ldsw = (unsigned)wid * 1024u;
    const int aoff = lds_byte(wr * 64 + fr, fq * 8), boff = lds_byte(wc * 32 + fr, fq * 8);
#define PG8_SA(b, h) (((b) * 2 + (h)) * HTB)
#define PG8_SB(b, h) ((4 + (b) * 2 + (h)) * HTB)
#define PG8_STAGE(bufoff, gbase, voff) do { _Pragma("unroll") for (int _i = 0; _i < 2; ++_i) \
        __builtin_amdgcn_global_load_lds((const unsigned*)((const char*)(gbase) + (voff)[_i]), (PG8_LAS unsigned*)(lds + (bufoff) + ldsw + _i * 8192), 16, 0, 0); } while (0)
#define PG8_LDA(dst, b, h) do { _Pragma("unroll") for (int m = 0; m < 4; ++m) _Pragma("unroll") for (int k = 0; k < 2; ++k) dst[m][k] = *(const PG8_LAS bf16x8*)(lds + PG8_SA(b, h) + aoff + m * 2048 + k * 1024); } while (0)
#define PG8_LDB(dst, b, h) do { _Pragma("unroll") for (int n = 0; n < 2; ++n) _Pragma("unroll") for (int k = 0; k < 2; ++k) dst[n][k] = *(const PG8_LAS bf16x8*)(lds + PG8_SB(b, h) + boff + n * 2048 + k * 1024); } while (0)
#define PG8_MMA(ai, bj, At, Bt) do { __builtin_amdgcn_s_setprio(1); _Pragma("unroll") for (int m = 0; m < 4; ++m) _Pragma("unroll") for (int n = 0; n < 2; ++n) _Pragma("unroll") for (int k = 0; k < 2; ++k) \
        acc[ai][bj][m][n] = __builtin_amdgcn_mfma_f32_16x16x32_bf16(Bt[n][k], At[m][k], acc[ai][bj][m][n], 0, 0, 0); __builtin_amdgcn_s_setprio(0); } while (0)
#define PG8_WAIT_V(n) asm volatile("s_waitcnt vmcnt(" #n ")" ::: "memory")
#define PG8_WAIT_L(n) asm volatile("s_waitcnt lgkmcnt(" #n ")" ::: "memory")
#define PG8_BAR __builtin_amdgcn_s_barrier()
#define PG8_SCHED __builtin_amdgcn_sched_barrier(0)
    Unit cur, nxt; int ui = 0;
    if (!S.next(0, cur)) return;
    f32x4 acc[2][2][4][2];
    if constexpr (Epi::INIT) E.init(acc, cur, wr, wc, fr, fq);
    else {
#pragma unroll
    for (int a = 0; a < 2; ++a)
#pragma unroll
        for (int b = 0; b < 2; ++b)
#pragma unroll
            for (int m = 0; m < 4; ++m)
#pragma unroll
                for (int n = 0; n < 2; ++n) acc[a][b][m][n] = (f32x4){0.f, 0.f, 0.f, 0.f};
    }
    bf16x8 At[4][2], B0[2][2], B1[2][2];
    const char* cA = (const char*)g.A + (size_t)cur.pm * tstepA; const char* cB = (const char*)g.Bt + (size_t)cur.pn * tstepB;
    S.a_ready(cur);
    if constexpr (SP2) {
        PG8_STAGE(PG8_SB(0, 0), cB, voffB); PG8_STAGE(PG8_SB(0, 1), cB + hstepB, voffB); PG8_STAGE(PG8_SA(0, 0), cA, voffA); PG8_STAGE(PG8_SA(0, 1), cA + hstepA, voffA);
        H(tid);
        if (wr == 1) PG8_BAR;
        PG8_WAIT_V(2); PG8_BAR;
        PG8_STAGE(PG8_SB(1, 0), cB + kstepB, voffB); PG8_STAGE(PG8_SA(1, 0), cA + kstepA, voffA); PG8_STAGE(PG8_SB(1, 1), cB + hstepB + kstepB, voffB);
        PG8_WAIT_V(6); PG8_BAR;
    } else {
        PG8_STAGE(PG8_SB(0, 0), cB, voffB); PG8_STAGE(PG8_SA(0, 0), cA, voffA); PG8_STAGE(PG8_SB(0, 1), cB + hstepB, voffB); PG8_STAGE(PG8_SA(0, 1), cA + hstepA, voffA);
        if (wr == 1) PG8_BAR;
        PG8_WAIT_V(4); PG8_BAR;
        PG8_STAGE(PG8_SB(1, 0), cB + kstepB, voffB); PG8_STAGE(PG8_SA(1, 0), cA + kstepA, voffA); PG8_STAGE(PG8_SB(1, 1), cB + hstepB + kstepB, voffB);
        PG8_WAIT_V(6); PG8_BAR;
    }
    for (;;) {
        const bool has_next = S.next(ui + 1, nxt);
        const char* nA = has_next ? (const char*)g.A + (size_t)nxt.pm * tstepA : cA; const char* nB = has_next ? (const char*)g.Bt + (size_t)nxt.pn * tstepB : cB;
        for (int t = 0; t < nt; t += 2) {
            const bool last = (t == nt - 2);
            const char* a1 = cA + (size_t)(t + 1) * kstepA;
            const char* a2 = last ? nA : cA + (size_t)(t + 2) * kstepA; const char* b2 = last ? nB : cB + (size_t)(t + 2) * kstepB;
            const char* a3 = a2 + kstepA; const char* b3 = b2 + kstepB;
            if (last && has_next) S.a_ready(nxt);
            if constexpr (SP2) {
            PG8_LDB(B0, 0, 0); PG8_LDB(B1, 0, 1); PG8_SCHED; PG8_LDA(At, 0, 0); PG8_STAGE(PG8_SA(1, 1), a1 + hstepA, voffA);
            PG8_WAIT_V(8); PG8_WAIT_L(0); PG8_BAR; PG8_MMA(0, 0, At, B0); PG8_MMA(0, 1, At, B1); PG8_BAR; PG8_SCHED;
            PG8_LDA(At, 0, 1); PG8_STAGE(PG8_SB(0, 0), b2, voffB); PG8_STAGE(PG8_SB(0, 1), b2 + hstepB, voffB); PG8_STAGE(PG8_SA(0, 0), a2, voffA);
            PG8_WAIT_V(8); PG8_WAIT_L(0); PG8_BAR; PG8_MMA(1, 0, At, B0); PG8_MMA(1, 1, At, B1); PG8_BAR; PG8_SCHED;
            PG8_LDB(B0, 1, 0); PG8_LDB(B1, 1, 1); PG8_SCHED; PG8_LDA(At, 1, 0); PG8_STAGE(PG8_SA(0, 1), a2 + hstepA, voffA);
            PG8_WAIT_V(8); PG8_WAIT_L(0); PG8_BAR; PG8_MMA(0, 0, At, B0); PG8_MMA(0, 1, At, B1); PG8_BAR; PG8_SCHED;
            PG8_LDA(At, 1, 1); PG8_STAGE(PG8_SB(1, 0), b3, voffB); PG8_STAGE(PG8_SB(1, 1), b3 + hstepB, voffB); PG8_STAGE(PG8_SA(1, 0), a3, voffA);
            PG8_WAIT_V(8); PG8_WAIT_L(0); PG8_BAR; PG8_MMA(1, 0, At, B0); PG8_MMA(1, 1, At, B1); PG8_BAR; PG8_SCHED;
            } else {
            PG8_LDB(B0, 0, 0); PG8_SCHED; PG8_LDA(At, 0, 0); PG8_STAGE(PG8_SA(1, 1), a1 + hstepA, voffA);
            PG8_WAIT_L(8); PG8_BAR; PG8_WAIT_L(0); PG8_MMA(0, 0, At, B0); PG8_BAR; PG8_SCHED;
            PG8_LDB(B1, 0, 1); PG8_STAGE(PG8_SB(0, 0), b2, voffB);
            PG8_BAR; PG8_WAIT_L(0); PG8_MMA(0, 1, At, B1); PG8_BAR;
            PG8_LDA(At, 0, 1); PG8_STAGE(PG8_SA(0, 0), a2, voffA);
            PG8_BAR; PG8_WAIT_L(0); PG8_MMA(1, 0, At, B0); PG8_BAR; PG8_SCHED;
            PG8_STAGE(PG8_SB(0, 1), b2 + hstepB, voffB);
            PG8_WAIT_V(6); PG8_BAR; PG8_MMA(1, 1, At, B1); PG8_BAR;
            PG8_LDB(B0, 1, 0); PG8_SCHED; PG8_LDA(At, 1, 0); PG8_STAGE(PG8_SA(0, 1), a2 + hstepA, voffA);
            PG8_WAIT_L(8); PG8_BAR; PG8_WAIT_L(0); PG8_MMA(0, 0, At, B0); PG8_BAR; PG8_SCHED;
            PG8_LDB(B1, 1, 1); PG8_STAGE(PG8_SB(1, 0), b3, voffB);
            PG8_BAR; PG8_WAIT_L(0); PG8_MMA(0, 1, At, B1); PG8_BAR;
            PG8_LDA(At, 1, 1); PG8_STAGE(PG8_SA(1, 0), a3, voffA);
            PG8_BAR; PG8_WAIT_L(0); PG8_MMA(1, 0, At, B0); PG8_BAR; PG8_SCHED;
            PG8_STAGE(PG8_SB(1, 1), b3 + hstepB, voffB);
            PG8_WAIT_V(6); PG8_BAR; PG8_MMA(1, 1, At, B1); PG8_BAR;
            }
        }
        if constexpr (ALIGN_EPI) { if (wr == 0) PG8_BAR; }
        if constexpr (!Epi::AFTER_DRAIN) { E(acc, cur, wr, wc, fr, fq); S.done(cur); }
#ifdef EPI_REP
        if constexpr (Epi::IDEMP) { for (int q_ = 1; q_ < EPI_REP; ++q_) {
            _Pragma("unroll") for (int a = 0; a < 2; ++a) _Pragma("unroll") for (int b = 0; b < 2; ++b) _Pragma("unroll") for (int m = 0; m < 4; ++m) _Pragma("unroll") for (int n = 0; n < 2; ++n) asm volatile("" : "+v"(acc[a][b][m][n]));
            E(acc, cur, wr, wc, fr, fq); } }
#endif
        if (!has_next) break;
        if constexpr (Epi::INIT) E.init(acc, nxt, wr, wc, fr, fq);
        else {
#pragma unroll
        for (int a = 0; a < 2; ++a)
#pragma unroll
            for (int b = 0; b < 2; ++b)
#pragma unroll
                for (int m = 0; m < 4; ++m)
#pragma unroll
                    for (int n = 0; n < 2; ++n) acc[a][b][m][n] = (f32x4){0.f, 0.f, 0.f, 0.f};
        }
        cur = nxt; cA = nA; cB = nB; ++ui;
        if constexpr (ALIGN_EPI) { if (wr == 1) PG8_BAR; }
    }
    PG8_WAIT_V(0);
    if constexpr (!ALIGN_EPI) { if (wr == 0) PG8_BAR; }
    PG8_BAR;
    if constexpr (Epi::AFTER_DRAIN) { E.fused(acc, cur, wr, wc, fr, fq, lds, wid, lane); S.done(cur); }
#undef PG8_SA
#undef PG8_SB
#undef PG8_STAGE
#undef PG8_LDA
#undef PG8_LDB
#undef PG8_MMA
#undef PG8_WAIT_V
#undef PG8_WAIT_L
#undef PG8_BAR
#undef PG8_SCHED
}
}
namespace pg8 {
template <class Epi>
__device__ __forceinline__ void sample_wide_unit(PG8_LAS unsigned char* lds, PG8_LAS float* rsl, const bf16_t* Ximg, const bf16_t* Bimg, const float* SSQS, int unit  , const Epi& E) {
    int tid_ = threadIdx.x; asm volatile("" : "+v"(tid_));
    const int tid = tid_, wid = __builtin_amdgcn_readfirstlane(tid >> 6), lane = tid & 63, wc = wid & 3, kh = wid >> 2, fr = lane & 15, fq = lane >> 4;
    const int rb = unit & 7, pn = unit >> 3;
    const int pm = EP_MP / BM + (rb >> 2), ai = (rb >> 1) & 1, wr = rb & 1;
    constexpr int NT = 16;
    { const char* asrc = (const char*)Ximg + ((size_t)pm * NT * 2 + ai) * HTB + wr * 8192 + tid * 16; asm volatile("" : "+v"(asrc));
#pragma unroll
      for (int kt = 0; kt < NT; ++kt) __builtin_amdgcn_global_load_lds((const unsigned*)(asrc + (size_t)kt * 2 * HTB), (PG8_LAS unsigned*)(lds + kt * 8192 + wid * 1024), 16, 0, 0); }
    { const int r = tid >> 3, part = tid & 7; const float* q = SSQS + (size_t)(rb * 64 + r) * 64 + 8 * part;
      const f32x4 a = *(const f32x4*)q, b = *(const f32x4*)(q + 4);
      float s = ((a[0] + a[1]) + (a[2] + a[3])) + ((b[0] + b[1]) + (b[2] + b[3]));
      s += __int_as_float(__builtin_amdgcn_ds_bpermute((lane ^ 1) << 2, __float_as_int(s))); s += __int_as_float(__builtin_amdgcn_ds_bpermute((lane ^ 2) << 2, __float_as_int(s)));
      s += __int_as_float(__builtin_amdgcn_ds_bpermute((lane ^ 4) << 2, __float_as_int(s)));
      if (part == 0) rsl[r] = __builtin_amdgcn_rsqf(s * (1.0f / 1024.0f) + 1e-6f); }
    const unsigned laneoff = (unsigned)((fr * 64 + fq * 16) ^ ((fr >> 3) << 5));
    const char* bsrc = (const char*)Bimg + (size_t)pn * NT * 2 * HTB + (size_t)(8 * kh) * 2 * HTB + wc * 4096 + laneoff; asm volatile("" : "+v"(bsrc));
    constexpr int NST = 4;
    bf16x8 bq[NST][2][2][2];
#define SW_LOADB(st, i) do { _Pragma("unroll") for (int bj = 0; bj < 2; ++bj) _Pragma("unroll") for (int n = 0; n < 2; ++n) _Pragma("unroll") for (int k2 = 0; k2 < 2; ++k2) \
        bq[st][bj][n][k2] = *(const bf16x8*)(bsrc + (size_t)((i) * 2 + bj) * HTB + (n * 2 + k2) * 1024); } while (0)
    SW_LOADB(0, 0); SW_LOADB(1, 1); SW_LOADB(2, 2); SW_LOADB(3, 3);
    asm volatile("s_waitcnt vmcnt(32)" ::: "memory");
    __syncthreads();
    f32x4 acc[2][4][2];
#pragma unroll
    for (int bj = 0; bj < 2; ++bj)
#pragma unroll
        for (int m = 0; m < 4; ++m)
#pragma unroll
            for (int n = 0; n < 2; ++n) acc[bj][m][n] = (f32x4){0.f, 0.f, 0.f, 0.f};
#pragma unroll
    for (int i = 0; i < 8; ++i) {
        bf16x8 a[4][2];
#pragma unroll
        for (int m = 0; m < 4; ++m)
#pragma unroll
            for (int k2 = 0; k2 < 2; ++k2) a[m][k2] = *(const PG8_LAS bf16x8*)(lds + (8 * kh + i) * 8192 + (2 * m + k2) * 1024 + laneoff);
#pragma unroll
        for (int k2 = 0; k2 < 2; ++k2)
#pragma unroll
            for (int bj = 0; bj < 2; ++bj)
#pragma unroll
                for (int m = 0; m < 4; ++m)
#pragma unroll
                    for (int n = 0; n < 2; ++n) acc[bj][m][n] = __builtin_amdgcn_mfma_f32_16x16x32_bf16(bq[i % NST][bj][n][k2], a[m][k2], acc[bj][m][n], 0, 0, 0);
        if (i + NST < 8) SW_LOADB(i % NST, i + NST);
    }
#undef SW_LOADB
    __syncthreads();
    PG8_LAS f32x4* xch = (PG8_LAS f32x4*)lds;
    f32x4 fin[2][2][2];
    if (kh == 0) {
#pragma unroll
        for (int bj = 0; bj < 2; ++bj)
#pragma unroll
            for (int m2 = 0; m2 < 2; ++m2)
#pragma unroll
                for (int n = 0; n < 2; ++n) xch[(((wid * 2 + bj) * 2 + m2) * 2 + n) * 64 + lane] = acc[bj][2 + m2][n];
    } else {
#pragma unroll
        for (int bj = 0; bj < 2; ++bj)
#pragma unroll
            for (int m2 = 0; m2 < 2; ++m2)
#pragma unroll
                for (int n = 0; n < 2; ++n) xch[(((wid * 2 + bj) * 2 + m2) * 2 + n) * 64 + lane] = acc[bj][m2][n];
    }
    __syncthreads();
    { const int pw = wid ^ 4;
      if (kh == 0) {
#pragma unroll
        for (int bj = 0; bj < 2; ++bj)
#pragma unroll
            for (int m2 = 0; m2 < 2; ++m2)
#pragma unroll
                for (int n = 0; n < 2; ++n) fin[bj][m2][n] = acc[bj][m2][n] + xch[(((pw * 2 + bj) * 2 + m2) * 2 + n) * 64 + lane];
      } else {
#pragma unroll
        for (int bj = 0; bj < 2; ++bj)
#pragma unroll
            for (int m2 = 0; m2 < 2; ++m2)
#pragma unroll
                for (int n = 0; n < 2; ++n) fin[bj][m2][n] = acc[bj][2 + m2][n] + xch[(((pw * 2 + bj) * 2 + m2) * 2 + n) * 64 + lane];
      } }
#pragma unroll
    for (int m2 = 0; m2 < 2; ++m2) {
        const int rl = (2 * kh + m2) * 16 + fr;
        const f32x4 v[2][2] = {{fin[0][m2][0], fin[0][m2][1]}, {fin[1][m2][0], fin[1][m2][1]}};
        E.rowgrp(v, EP_MP + rb * 64 + rl, rsl[rl], pn, wc, fr, fq);
    }
    __syncthreads();
}
}
#include <hip/hip_bf16.h>
#include <cmath>
namespace attn_body {
using bf16=__hip_bfloat16;
using bf16x8=__attribute__((ext_vector_type(8)))short;
using s16x4=__attribute__((ext_vector_type(4)))short;
using f32x16=__attribute__((ext_vector_type(16)))float;
using u32x4=__attribute__((ext_vector_type(4)))unsigned;
constexpr int BATCH=2,NHEAD=16,SEQ=16384,D=64,DM=NHEAD*D;
constexpr int NW=8,QBLK=32,QB=QBLK*NW,KVBLK=64,NQB=SEQ/QB;
constexpr int ATTN_PITCH=DM, ATTN_UNIT_ROWS=QB;
__device__ __forceinline__ int crow(int r,int hi){return (r&3)+8*(r>>2)+4*hi;}
#define SBAR() __builtin_amdgcn_sched_barrier(0)
__device__ __forceinline__ void cmask(f32x16&p0,f32x16&p1,int jb,int qrel,int hi){
  const float NEG=-INFINITY; int kb=64*jb+4*hi;
  #pragma unroll
  for(int r=0;r<16;++r){int kv=kb+(r&3)+8*(r>>2); if(kv>qrel)p0[r]=NEG; if(kv+32>qrel)p1[r]=NEG;}
}

constexpr int NSLOT=3, SLOTB=8192;
constexpr int LDS_K=0, LDS_V=NSLOT*SLOTB, LDS_WS=2*NSLOT*SLOTB, LDS_OST=LDS_WS+NW*64*4, LDS_CB=LDS_OST+NW*4096, LDS_BYTES=LDS_CB+NW*768;
constexpr float C2=0.125f*1.4426950408889634f;
__device__ __forceinline__ void glds16(const void*gsrc,unsigned lds_dst){unsigned keep;
  asm volatile("s_mov_b32 %0, m0\n\ts_mov_b32 m0, %2\n\ts_nop 0\n\tglobal_load_lds_dwordx4 %1, off\n\ts_mov_b32 m0, %0":"=&s"(keep):"v"(gsrc),"s"(lds_dst):"memory");}
__device__ __forceinline__ void glds16s(const void*sbase,unsigned voff,unsigned lds_dst){unsigned keep;
  asm volatile("s_nop 4\n\ts_mov_b32 %0, m0\n\ts_mov_b32 m0, %3\n\ts_nop 0\n\tglobal_load_lds_dwordx4 %1, %2\n\ts_mov_b32 m0, %0":"=&s"(keep):"v"(voff),"s"(sbase),"s"(lds_dst):"memory");}
__device__ __forceinline__ void glds4s(const void*sbase,unsigned voff,unsigned lds_dst){unsigned keep;
  asm volatile("s_nop 4\n\ts_mov_b32 %0, m0\n\ts_mov_b32 m0, %3\n\ts_nop 0\n\tglobal_load_lds_dword %1, %2\n\ts_mov_b32 m0, %0":"=&s"(keep):"v"(voff),"s"(sbase),"s"(lds_dst):"memory");}
__device__ __forceinline__ float max3f(float a,float b,float c){float r;asm("v_max3_f32 %0, %1, %2, %3":"=v"(r):"v"(a),"v"(b),"v"(c));return r;}
__device__ __forceinline__ float max2f(float a,float b){float r;asm("v_max_f32_e32 %0, %1, %2":"=v"(r):"v"(a),"v"(b));return r;}
__device__ __forceinline__ float fadd_s(float a,float b){float r;asm("v_add_f32_e32 %0, %1, %2":"=v"(r):"v"(a),"v"(b));return r;}
__device__ __forceinline__ float fsub_s(float a,float b){float r;asm("v_sub_f32_e32 %0, %1, %2":"=v"(r):"v"(a),"v"(b));return r;}
typedef float f32x4_t __attribute__((ext_vector_type(4))); typedef float f32x2_t __attribute__((ext_vector_type(2))); typedef __bf16 bf16x2_t __attribute__((ext_vector_type(2)));
__device__ __forceinline__ unsigned cvtpk_s(float lo,float hi){f32x2_t v={lo,hi};bf16x2_t b=__builtin_convertvector(v,bf16x2_t);return __builtin_bit_cast(unsigned,b);}
#define WAIT_BAR(N) asm volatile("s_waitcnt vmcnt(" #N ") lgkmcnt(0)\n\ts_barrier":::"memory")

__device__ __forceinline__ void qkt(f32x16&p0,f32x16&p1,const char*Kslot,const bf16x8*qr,const f32x16&negm,int r32,int hi){
  const char*kb=Kslot+hi*1024+r32*16;
  #pragma unroll
  for(int d0=0;d0<4;++d0){
    const bf16x8 b0=*reinterpret_cast<const bf16x8*>(kb+d0*2048);
    const bf16x8 b1=*reinterpret_cast<const bf16x8*>(kb+d0*2048+512);
    if(d0==0){p0=__builtin_amdgcn_mfma_f32_32x32x16_bf16(b0,qr[0],negm,0,0,0);p1=__builtin_amdgcn_mfma_f32_32x32x16_bf16(b1,qr[0],negm,0,0,0);}
    else{p0=__builtin_amdgcn_mfma_f32_32x32x16_bf16(b0,qr[d0],p0,0,0,0);p1=__builtin_amdgcn_mfma_f32_32x32x16_bf16(b1,qr[d0],p1,0,0,0);}}
}
typedef __attribute__((address_space(3))) const char* lds_cptr;
typedef short v4i16_t __attribute__((ext_vector_type(4)));
__device__ __forceinline__ void kload8(bf16x8*kf,lds_cptr kp){
  kf[0]=*(const __attribute__((address_space(3))) bf16x8*)(kp);      kf[1]=*(const __attribute__((address_space(3))) bf16x8*)(kp+512);
  kf[2]=*(const __attribute__((address_space(3))) bf16x8*)(kp+2048); kf[3]=*(const __attribute__((address_space(3))) bf16x8*)(kp+2560);
  kf[4]=*(const __attribute__((address_space(3))) bf16x8*)(kp+4096); kf[5]=*(const __attribute__((address_space(3))) bf16x8*)(kp+4608);
  kf[6]=*(const __attribute__((address_space(3))) bf16x8*)(kp+6144); kf[7]=*(const __attribute__((address_space(3))) bf16x8*)(kp+6656);
}
__device__ __forceinline__ void kload2(bf16x8*kf,lds_cptr kp,int j){ kf[2*j]=*(const __attribute__((address_space(3))) bf16x8*)(kp+j*2048); kf[2*j+1]=*(const __attribute__((address_space(3))) bf16x8*)(kp+j*2048+512); }
__device__ __forceinline__ s16x4 vtr(lds_cptr p){ return __builtin_bit_cast(s16x4,__builtin_amdgcn_ds_read_tr16_b64_v4i16((__attribute__((address_space(3))) v4i16_t*)p)); }
__device__ __forceinline__ float rowmax(const f32x16&p0,const f32x16&p1){
  float a=max3f(p0[0],p0[1],p1[0]),b=max3f(p0[2],p0[3],p1[1]);a=max3f(a,p1[2],p1[3]);
  #pragma unroll
  for(int r=4;r<16;r+=4){a=max3f(a,p0[r],p0[r+1]);b=max3f(b,p0[r+2],p0[r+3]);a=max3f(a,p1[r],p1[r+1]);b=max3f(b,p1[r+2],p1[r+3]);}
  const float m=max2f(a,b);
  auto rr=__builtin_amdgcn_permlane32_swap(__float_as_uint(m),__float_as_uint(m),false,false);
  return max2f(__uint_as_float(rr[0]),__uint_as_float(rr[1]));
}
__device__ __forceinline__ void pv(f32x16*o,int vb,bf16x8 pa0,bf16x8 pa1,bf16x8 pa2,bf16x8 pa3){
  #pragma unroll
  for(int d0=0;d0<2;++d0){s16x4 lo[4],hi[4];
    #pragma unroll
    for(int ks=0;ks<4;++ks){
      asm volatile("ds_read_b64_tr_b16 %0,%1 offset:%c2":"=&v"(lo[ks]):"v"(vb),"i"(d0*4096+ks*1024):"memory");
      asm volatile("ds_read_b64_tr_b16 %0,%1 offset:%c2":"=&v"(hi[ks]):"v"(vb),"i"(d0*4096+ks*1024+512):"memory");}
    asm volatile("s_waitcnt lgkmcnt(0)":::"memory");SBAR();
    #define PK(k) (bf16x8){lo[k][0],lo[k][1],lo[k][2],lo[k][3],hi[k][0],hi[k][1],hi[k][2],hi[k][3]}
    o[d0]=__builtin_amdgcn_mfma_f32_32x32x16_bf16(pa0,PK(0),o[d0],0,0,0);
    o[d0]=__builtin_amdgcn_mfma_f32_32x32x16_bf16(pa1,PK(1),o[d0],0,0,0);
    o[d0]=__builtin_amdgcn_mfma_f32_32x32x16_bf16(pa2,PK(2),o[d0],0,0,0);
    o[d0]=__builtin_amdgcn_mfma_f32_32x32x16_bf16(pa3,PK(3),o[d0],0,0,0);
    #undef PK
  }
}

#ifndef ATTN_STORE16
#define ATTN_STORE16(p,v) (*(u32x4*)(p)=(v))
#endif
template<int THRL> __device__ __forceinline__ void attn_unit(int b,int h,int qb,int t0,const bf16*Q,const bf16*__restrict__ K,const bf16*__restrict__ V,const bf16*__restrict__ G,const float*__restrict__ ND,bf16*O,char*shm){
  int tid_=threadIdx.x; asm volatile("":"+v"(tid_)); const int tid=tid_,lane=tid&63,r32=lane&31,hi=lane>>5; const int wid=__builtin_amdgcn_readfirstlane(tid>>6);
  const long rowbase=(long)b*SEQ; const int q0=qb*QB;
  const bf16*Qw=Q+(rowbase+q0+wid*QBLK)*DM+h*D;
  const bf16*Kh=K+(rowbase+(long)t0*KVBLK)*DM+h*D,*Vh=V+(rowbase+(long)t0*KVBLK)*DM+h*D;
  const float*NDh=ND+((long)b*NHEAD+h)*SEQ; const float*Ct0=NDh+(long)t0*KVBLK;
  const unsigned lds0=(unsigned)(uintptr_t)shm;
  float*wsf=(float*)(shm+LDS_WS)+wid*64;
  const unsigned koff=(unsigned)(lane*DM+wid*8)*2u;
  const unsigned voff=(unsigned)((16*(wid&3)+(lane>>2))*DM+(wid>>2)*32+(lane&3)*8)*2u;
  const unsigned kdst=lds0+LDS_K+wid*1024, vdst=lds0+LDS_V+wid*1024;
  #define DMA_K(t,slot) glds16s(Kh+(long)(t)*KVBLK*DM,koff,(unsigned)__builtin_amdgcn_readfirstlane(kdst+(slot)))
  #define DMA_V(t,slot) glds16s(Vh+(long)(t)*KVBLK*DM,voff,(unsigned)__builtin_amdgcn_readfirstlane(vdst+(slot)))
  const unsigned cdst=lds0+LDS_CB+wid*768;
  #define DMA_C(t,slot) glds4s(Ct0+(long)(t)*KVBLK,(unsigned)lane*4u,(unsigned)__builtin_amdgcn_readfirstlane(cdst+((slot)>>5)))
  const lds_cptr cbp0=(lds_cptr)shm+LDS_CB+wid*768+hi*16;
  #define BIAS(P0,P1,slot) do{ const lds_cptr cb_=cbp0+((slot)>>5); _Pragma("unroll") for(int g_=0;g_<4;++g_){ const f32x4_t b0_=*(const __attribute__((address_space(3))) f32x4_t*)(cb_+g_*32), b1_=*(const __attribute__((address_space(3))) f32x4_t*)(cb_+128+g_*32); \
      P0[4*g_]+=b0_[0];P0[4*g_+1]+=b0_[1];P0[4*g_+2]+=b0_[2];P0[4*g_+3]+=b0_[3]; P1[4*g_]+=b1_[0];P1[4*g_+1]+=b1_[1];P1[4*g_+2]+=b1_[2];P1[4*g_+3]+=b1_[3]; } }while(0)
  const int vb0=(int)(lds0+LDS_V)+((lane>>4)&1)*32+(lane&3)*8+(4*hi+((lane&15)>>2))*64;
  const char*Kbase=shm+LDS_K; bf16x8 kf[8];
  const lds_cptr shm3=(lds_cptr)shm; const lds_cptr kp0=shm3+LDS_K+hi*1024+r32*16; const lds_cptr vp0=shm3+LDS_V+((lane>>4)&1)*32+(lane&3)*8+(4*hi+((lane&15)>>2))*64;
  const int NT=(q0+QB)/KVBLK-t0;
  DMA_K(0,0);DMA_C(0,0);DMA_V(0,0);DMA_K(1,SLOTB);
  bf16x8 qr[4];
  #pragma unroll
  for(int d0=0;d0<4;++d0)qr[d0]=*reinterpret_cast<const bf16x8*>(&Qw[(long)r32*DM+d0*16+hi*8]);
  const float ndi=NDh[q0+wid*QBLK+r32];
  float mhat,l_reg=0.f;f32x16 o[2];o[0]=f32x16{};o[1]=f32x16{};f32x16 negm;
  const int qrel=wid*QBLK+r32;
  #define CMASK(P0,P1,t) do{int jb_=(t)-(NT-4); if(jb_>=0)cmask(P0,P1,jb_,qrel,hi);}while(0)
  bool resc=false;
  #define START(P0,P1) do{ const float rm=rowmax(P0,P1); resc=false; \
    { const float dl=max2f(rm,0.f); mhat=fadd_s(mhat,dl); \
      _Pragma("unroll") for(int r=0;r<16;++r){P0[r]=fsub_s(P0[r],dl);P1[r]=fsub_s(P1[r],dl);} \
      _Pragma("unroll") for(int r=0;r<16;++r)negm[r]=-mhat; asm volatile("":"+v"(negm)); } \
    _Pragma("unroll") for(int r=0;r<16;++r)P0[r]=__builtin_amdgcn_exp2f(P0[r]); }while(0)
  #define RESC() do{ if(resc){ asm volatile("s_waitcnt lgkmcnt(0)":::"memory"); \
      _Pragma("unroll") for(int d_=0;d_<2;++d_) _Pragma("unroll") for(int r=0;r<16;++r)o[d_][r]*=wsf[crow(r,hi)]; } }while(0)
  f32x16 pA0,pA1,pB0,pB1;
  int sl_prev=0,sl_cur=0,sl_next=SLOTB;
  #define ROT() do{sl_prev=sl_cur;sl_cur=sl_next;sl_next=(sl_next==(NSLOT-1)*SLOTB)?0:sl_next+SLOTB;}while(0)
  DMA_K(2,2*SLOTB);DMA_C(1,SLOTB);
  WAIT_BAR(3);
  mhat=ndi; _Pragma("unroll") for(int r=0;r<16;++r)negm[r]=-ndi; asm volatile("":"+v"(negm));
  qkt(pA0,pA1,Kbase,qr,negm,r32,hi);asm volatile("s_nop 15\n\ts_nop 7":"+v"(pA0),"+v"(pA1));BIAS(pA0,pA1,0);CMASK(pA0,pA1,0);
  START(pA0,pA1);
  _Pragma("unroll") for(int r=0;r<16;++r)pA1[r]=__builtin_amdgcn_exp2f(pA1[r]);
  WAIT_BAR(0);
  DMA_K(3,0);DMA_V(1,SLOTB);DMA_C(2,2*SLOTB);
  ROT();
  kload8(kf,kp0+sl_cur);
  WAIT_BAR(3);
  s16x4 vlo[8],vhi[8]; u32x4 pw0,pw1,pw2,pw3;
  #define PKW(P,B) cvtpk_s(P[B],P[B+1])
  #define PAF(k) __builtin_bit_cast(bf16x8,pw##k)
  #define VFR(i) (bf16x8){vlo[i][0],vlo[i][1],vlo[i][2],vlo[i][3],vhi[i][0],vhi[i][1],vhi[i][2],vhi[i][3]}
  #define PIN(x) asm volatile("":"+v"(x))
  #define MX3(a,b,c) __builtin_fmaxf(__builtin_fmaxf((a),(b)),(c))
  #define GAPA(MF,A0,A1,A2,A3,W0,W1,PW) do{ MF; sacc+=A0; sacc+=A1; sacc+=A2; sacc+=A3; PIN(sacc); W0; W1; PIN(PW); SBAR(); }while(0)
  #define EX(v) __builtin_amdgcn_exp2f(v)
  #define GAPB(MF,X,B) do{ MF; X[B]=EX(X[B]); X[B+1]=EX(X[B+1]); X[B+2]=EX(X[B+2]); X[B+3]=EX(X[B+3]); PIN(X); SBAR(); }while(0)
  #define VRD(i) do{ vlo[i]=vtr(vp_+(((i)>>2)*4096+((i)&3)*1024)); vhi[i]=vtr(vp_+(((i)>>2)*4096+((i)&3)*1024+512)); }while(0)
  #define KRD(G,j) do{ if(G){ kload2(kf,kp0+sl_next,j); SBAR(); } }while(0)
  #define STEP(C0,C1,P0,P1,t,GK,GV,GL,GC) do{ SBAR(); \
    const lds_cptr vp_=vp0+sl_prev; \
    VRD(0); SBAR(); float sacc=(P0[0]+P0[1]); \
    GAPA(C0=__builtin_amdgcn_mfma_f32_32x32x16_bf16(kf[0],qr[0],negm,0,0,0), P0[2],P0[3],P0[4],P0[5],     pw0[0]=PKW(P0,0), pw0[1]=PKW(P0,2), pw0); \
    VRD(4); SBAR(); GAPA(C1=__builtin_amdgcn_mfma_f32_32x32x16_bf16(kf[1],qr[0],negm,0,0,0), P0[6],P0[7],P0[8],P0[9],     pw0[2]=PKW(P0,4), pw0[3]=PKW(P0,6), pw0); \
    VRD(1); SBAR(); GAPA(C0=__builtin_amdgcn_mfma_f32_32x32x16_bf16(kf[2],qr[1],C0,0,0,0),   P0[10],P0[11],P0[12],P0[13], pw1[0]=PKW(P0,8), pw1[1]=PKW(P0,10), pw1); \
    VRD(5); SBAR(); GAPA(C1=__builtin_amdgcn_mfma_f32_32x32x16_bf16(kf[3],qr[1],C1,0,0,0),   P0[14],P0[15],P1[0],P1[1],   pw1[2]=PKW(P0,12),pw1[3]=PKW(P0,14), pw1); \
    VRD(2); SBAR(); GAPA(C0=__builtin_amdgcn_mfma_f32_32x32x16_bf16(kf[4],qr[2],C0,0,0,0),   P1[2],P1[3],P1[4],P1[5],     pw2[0]=PKW(P1,0), pw2[1]=PKW(P1,2), pw2); \
    VRD(6); SBAR(); GAPA(C1=__builtin_amdgcn_mfma_f32_32x32x16_bf16(kf[5],qr[2],C1,0,0,0),   P1[6],P1[7],P1[8],P1[9],     pw2[2]=PKW(P1,4), pw2[3]=PKW(P1,6), pw2); \
    VRD(3); SBAR(); GAPA(C0=__builtin_amdgcn_mfma_f32_32x32x16_bf16(kf[6],qr[3],C0,0,0,0),   P1[10],P1[11],P1[12],P1[13], pw3[0]=PKW(P1,8), pw3[1]=PKW(P1,10), pw3); \
    VRD(7); SBAR(); GAPA(C1=__builtin_amdgcn_mfma_f32_32x32x16_bf16(kf[7],qr[3],C1,0,0,0),   P1[14],P1[15],0.f,0.f,       pw3[2]=PKW(P1,12),pw3[3]=PKW(P1,14), pw3); \
    l_reg+=sacc; \
    if(GK){DMA_K((t)+3,sl_cur);} if(GV){DMA_V((t)+1,sl_next);} if(GC){DMA_C((t)+2,sl_prev);} \
    BIAS(C0,C1,sl_cur); CMASK(C0,C1,t); \
    { float a=MX3(C0[0],C0[1],C1[0]),b=MX3(C0[2],C0[3],C1[1]); a=MX3(a,C1[2],C1[3]); \
      _Pragma("unroll") for(int r=4;r<16;r+=4){a=MX3(a,C0[r],C0[r+1]);b=MX3(b,C0[r+2],C0[r+3]);a=MX3(a,C1[r],C1[r+1]);b=MX3(b,C1[r+2],C1[r+3]);} \
      float rm=__builtin_fmaxf(a,b); { auto rr=__builtin_amdgcn_permlane32_swap(__float_as_uint(rm),__float_as_uint(rm),false,false); rm=__builtin_fmaxf(__uint_as_float(rr[0]),__uint_as_float(rr[1])); } \
      resc=false; \
      if(__builtin_expect(__any(rm>(float)THRL),0)){ const float dl=__builtin_fmaxf(rm,0.f); mhat+=dl; \
        _Pragma("unroll") for(int r=0;r<16;++r){C0[r]-=dl;C1[r]-=dl;} \
        _Pragma("unroll") for(int r=0;r<16;++r)negm[r]=-mhat; asm volatile("":"+v"(negm)); \
        const float f=__builtin_amdgcn_exp2f(-dl); l_reg*=f; if(hi==0)wsf[r32]=f; resc=true; } } \
    SBAR(); \
    GAPB(o[0]=__builtin_amdgcn_mfma_f32_32x32x16_bf16(PAF(0),VFR(0),o[0],0,0,0), C0,0); \
    GAPB(o[1]=__builtin_amdgcn_mfma_f32_32x32x16_bf16(PAF(0),VFR(4),o[1],0,0,0), C0,4); \
    KRD(GL,0); GAPB(o[0]=__builtin_amdgcn_mfma_f32_32x32x16_bf16(PAF(1),VFR(1),o[0],0,0,0), C0,8); \
    KRD(GL,1); GAPB(o[1]=__builtin_amdgcn_mfma_f32_32x32x16_bf16(PAF(1),VFR(5),o[1],0,0,0), C0,12); \
    KRD(GL,2); GAPB(o[0]=__builtin_amdgcn_mfma_f32_32x32x16_bf16(PAF(2),VFR(2),o[0],0,0,0), C1,0); \
    KRD(GL,3); GAPB(o[1]=__builtin_amdgcn_mfma_f32_32x32x16_bf16(PAF(2),VFR(6),o[1],0,0,0), C1,4); \
    GAPB(o[0]=__builtin_amdgcn_mfma_f32_32x32x16_bf16(PAF(3),VFR(3),o[0],0,0,0), C1,8); \
    GAPB(o[1]=__builtin_amdgcn_mfma_f32_32x32x16_bf16(PAF(3),VFR(7),o[1],0,0,0), C1,12); \
    }while(0)
  int t=1;
  #undef CMASK
  #define CMASK(P0,P1,t) do{}while(0)
  for(;t+5<NT;t+=2){
    STEP(pB0,pB1,pA0,pA1,t,true,true,true,true);     WAIT_BAR(3); RESC(); ROT();
    STEP(pA0,pA1,pB0,pB1,t+1,true,true,true,true);   WAIT_BAR(3); RESC(); ROT();
  }
  #undef CMASK
  #define CMASK(P0,P1,t) do{int jb_=(t)-(NT-4); if(jb_>=0)cmask(P0,P1,jb_,qrel,hi);}while(0)
  #define ENDW(tt) do{ if((tt)+3<NT){WAIT_BAR(3);} else if((tt)+2<NT){WAIT_BAR(2);} else {WAIT_BAR(0);} }while(0)
  for(;t+1<NT;t+=2){
    STEP(pB0,pB1,pA0,pA1,t,(t+3<NT),(t+1<NT),(t+1<NT),(t+2<NT));       ENDW(t);   RESC(); ROT();
    STEP(pA0,pA1,pB0,pB1,t+1,(t+4<NT),(t+2<NT),(t+2<NT),(t+3<NT));     ENDW(t+1); RESC(); ROT();
  }
  STEP(pB0,pB1,pA0,pA1,NT-1,false,false,false,false); RESC();
  { float sacc=pB0[0]+pB0[1]; _Pragma("unroll") for(int r=2;r<16;++r)sacc+=pB0[r]; _Pragma("unroll") for(int r=0;r<16;++r)sacc+=pB1[r]; l_reg+=sacc;
    pw0=(u32x4){PKW(pB0,0),PKW(pB0,2),PKW(pB0,4),PKW(pB0,6)};pw1=(u32x4){PKW(pB0,8),PKW(pB0,10),PKW(pB0,12),PKW(pB0,14)};pw2=(u32x4){PKW(pB1,0),PKW(pB1,2),PKW(pB1,4),PKW(pB1,6)};pw3=(u32x4){PKW(pB1,8),PKW(pB1,10),PKW(pB1,12),PKW(pB1,14)};
    SBAR(); pv(o,vb0+sl_cur,PAF(0),PAF(1),PAF(2),PAF(3)); }
  #undef PKW
  #undef PAF
  #undef VFR
  #undef PIN
  #undef MX3
  #undef GAPA
  #undef GAPB
  #undef EX
  #undef VRD
  #undef KRD
  #undef STEP
  #undef ENDW
  {auto rr=__builtin_amdgcn_permlane32_swap(__float_as_uint(l_reg),__float_as_uint(l_reg),false,false);l_reg=__uint_as_float(rr[0])+__uint_as_float(rr[1]);}
  if(hi==0)wsf[32+r32]=l_reg;asm volatile("s_waitcnt lgkmcnt(0)":::"memory");
  float rli[16];
  #pragma unroll
  for(int r=0;r<16;++r)rli[r]=__builtin_amdgcn_rcpf(wsf[32+crow(r,hi)]);
  bf16*Ow=O+(rowbase+q0+wid*QBLK)*DM+h*D;
  { bf16*stg=(bf16*)(shm+LDS_OST)+wid*2048;
    #pragma unroll
    for(int r=0;r<16;++r){const int orow=crow(r,hi);
      #pragma unroll
      for(int d0=0;d0<2;++d0)stg[orow*64+d0*32+r32]=__float2bfloat16(o[d0][r]*rli[r]);}
    asm volatile("s_waitcnt lgkmcnt(0)":::"memory");
    const bf16*Gw=G+(rowbase+q0+wid*QBLK)*DM+h*D;
    #pragma unroll
    for(int i=0;i<4;++i){const int row=i*8+(lane>>3),ch=lane&7; const u32x4 v=*(const u32x4*)(stg+row*64+ch*8); const u32x4 g=*(const u32x4*)(Gw+(long)row*DM+ch*8); u32x4 w;
      #pragma unroll
      for(int e=0;e<4;++e){ const float a0=__uint_as_float(v[e]<<16)*__uint_as_float(g[e]<<16), a1=__uint_as_float(v[e]&0xffff0000u)*__uint_as_float(g[e]&0xffff0000u); w[e]=cvtpk_s(a0,a1); }
      ATTN_STORE16(Ow+(long)row*DM+ch*8,w);} }
  asm volatile("s_waitcnt lgkmcnt(0)\n\ts_barrier":::"memory");
  #undef DMA_K
  #undef DMA_V
  #undef DMA_C
  #undef BIAS
  #undef CMASK
  #undef START
  #undef RESC
  #undef ROT
}
constexpr int ATTN_LDS_BYTES=LDS_BYTES;
#undef SBAR
#undef WAIT_BAR
}
#define GAS __attribute__((address_space(1)))
#define LAS __attribute__((address_space(3)))
typedef unsigned short bf16;
typedef unsigned v4u __attribute__((ext_vector_type(4)));
typedef float f32x4 __attribute__((ext_vector_type(4)));
typedef short bf16x8 __attribute__((ext_vector_type(8)));
typedef GAS unsigned gu32;
typedef GAS unsigned long long gu64;
#define RLX_AGENT __ATOMIC_RELAXED, __HIP_MEMORY_SCOPE_AGENT
#define LDS_WAIT() asm volatile("s_waitcnt lgkmcnt(0)" ::: "memory")
#define VM_WAIT() asm volatile("s_waitcnt vmcnt(0)" ::: "memory")
__device__ __forceinline__ unsigned long long rt() { return __builtin_amdgcn_s_memrealtime(); }
__device__ __forceinline__ unsigned f2bf(float f) { unsigned u = __builtin_bit_cast(unsigned, f); return (u + 0x7fffu + ((u >> 16) & 1u)) >> 16; }
__device__ __forceinline__ unsigned pk2(float lo, float hi) { return f2bf(lo) | (f2bf(hi) << 16); }
__device__ __forceinline__ float bperm(float v, int srclane) { return __int_as_float(__builtin_amdgcn_ds_bpermute(srclane << 2, __float_as_int(v))); }
typedef unsigned u32x4q __attribute__((ext_vector_type(4)));
typedef short v4i16q __attribute__((ext_vector_type(4)));
__device__ __forceinline__ unsigned pkq(float lo, float hi) { typedef float f2_ __attribute__((ext_vector_type(2))); typedef __bf16 b2_ __attribute__((ext_vector_type(2))); f2_ v = {lo, hi}; b2_ b = __builtin_convertvector(v, b2_); return __builtin_bit_cast(unsigned, b); }
#define XB_TMO      128
#define XB_XCNT(j)  (256  + 64 * (j))
#define XB_XSUB(j)  (1280 + 64 * (j))
#define XB_XGEN(j)  (2304 + 64 * (j))
#define XB_TOP      3328
#define XB_TOPGEN   3392
#define XCD_BAR_WORDS 3456
#define XB_SPIN_CAP (1u << 18)

__device__ __forceinline__ unsigned xb_ld(unsigned* p)              { return __hip_atomic_load(p, __ATOMIC_RELAXED, __HIP_MEMORY_SCOPE_AGENT); }
__device__ __forceinline__ unsigned xb_add(unsigned* p, unsigned v) { return __hip_atomic_fetch_add(p, v, __ATOMIC_RELAXED, __HIP_MEMORY_SCOPE_AGENT); }
__device__ __forceinline__ unsigned xb_xcc_id() { return (unsigned)__builtin_amdgcn_s_getreg((3 << 11) | 20) & 0xFu; }
#define XB_SPIN(cond, bar) do { unsigned _sp = 0; while (cond) { __builtin_amdgcn_s_sleep(1); \
    if ((++_sp & 255u) == 0u) { if (xb_ld(&(bar)[XB_TMO])) break; if (_sp > XB_SPIN_CAP) { atomicAdd(&(bar)[XB_TMO], 1u); break; } } } } while (0)

struct XcdBarrier {
    unsigned* bar; unsigned x;
    volatile LAS unsigned* st;
};

__device__ __forceinline__ XcdBarrier xcd_barrier_post(unsigned* bar, volatile LAS unsigned* st) {
    XcdBarrier b; b.bar = bar; b.x = xb_xcc_id(); b.st = st;
    if (threadIdx.x == 0) (void)xb_add(&bar[XB_XCNT(b.x)], 1u);
    return b;
}
__device__ __forceinline__ void xcd_barrier_complete(unsigned* bar, unsigned x, unsigned& nloc, unsigned& nx) {
    const unsigned G = gridDim.x * gridDim.y * gridDim.z;
    unsigned sum, cnt, mine, sp = 0u;
    for (;;) {
        sum = 0u; cnt = 0u; mine = 0u;
#pragma unroll
        for (unsigned j = 0; j < 16; ++j) { const unsigned c = xb_ld(&bar[XB_XCNT(j)]); sum += c; cnt += (c > 0u) ? 1u : 0u; mine = (j == x) ? c : mine; }
        if (sum == G) break;
        __builtin_amdgcn_s_sleep(1);
        if ((++sp & 255u) == 0u) { if (xb_ld(&bar[XB_TMO])) break; if (sp > XB_SPIN_CAP) { atomicAdd(&bar[XB_TMO], 1u); break; } }
    }
    nloc = mine > 0u ? mine : 1u; nx = cnt > 0u ? cnt : 1u;
}

__device__ __forceinline__ void xcd_barrier(const XcdBarrier& b) {
    asm volatile("s_waitcnt vmcnt(0)" ::: "memory");
    __syncthreads();
    int t0_ = threadIdx.x; asm volatile("" : "+v"(t0_));
    if (t0_ == 0) {
        unsigned* bar = b.bar;
        __builtin_amdgcn_s_waitcnt(0);
        unsigned nloc = b.st[0], nx = b.st[1];
        if (nloc == 0u) { xcd_barrier_complete(bar, b.x, nloc, nx); b.st[0] = nloc; b.st[1] = nx; }
        const unsigned old = xb_add(&bar[XB_XSUB(b.x)], 1u);
        const unsigned gen = old / nloc;
        if (old + 1u == (gen + 1u) * nloc) {
            __builtin_amdgcn_fence(__ATOMIC_RELEASE, "agent");
            asm volatile("s_waitcnt vmcnt(0)" ::: "memory");
            const unsigned og = xb_add(&bar[XB_TOP], 1u);
            const unsigned tg = og / nx;
            if (og + 1u == (tg + 1u) * nx) xb_add(&bar[XB_TOPGEN], 1u);
            else XB_SPIN(xb_ld(&bar[XB_TOPGEN]) == tg, bar);
            __builtin_amdgcn_fence(__ATOMIC_ACQUIRE, "agent");
            xb_add(&bar[XB_XGEN(b.x)], 1u);
            asm volatile("s_waitcnt vmcnt(0)" ::: "memory");
        } else {
            XB_SPIN(xb_ld(&bar[XB_XGEN(b.x)]) == gen, bar);
            __builtin_amdgcn_fence(__ATOMIC_ACQUIRE, "agent");
            asm volatile("s_waitcnt vmcnt(0)" ::: "memory");
        }
    }
    __syncthreads();
}
constexpr int NWAVES = 8;
constexpr int DM = 1024, SEQ = 16384, NBATCH = 2, MP = NBATCH * SEQ, DEC_B = 16, DEC_S = 32, PAST = 2048, MS = DEC_B * DEC_S, M = MP + MS;
constexpr int FF = 2816, FOX_COLS = 4112;
constexpr float RMS_EPS = 1e-6f, GN_EPS = 1e-5f, LOG2E = 1.4426950408889634f;
constexpr size_t MiB = 1u << 20;
constexpr size_t WS_CTL = 0, CTL_ZERO_BYTES = 1 * MiB;
constexpr size_t WS_WF = 1 * MiB;
constexpr size_t WS_WFI = 2 * MiB, WFI_STRIDE = 11 * MiB;
constexpr size_t WS_WFO = 90 * MiB, WFO_STRIDE = 11 * MiB / 2;
constexpr size_t WS_WXI = 134 * MiB, WXI_STRIDE = 8 * MiB;
constexpr size_t WS_WXO = 150 * MiB, WXO_STRIDE = 2 * MiB;
constexpr size_t WS_WRI = 154 * MiB, WRI_STRIDE = 12 * MiB;
constexpr size_t WS_WRO = 178 * MiB, WRO_STRIDE = 4 * MiB;
constexpr size_t WS_X = 186 * MiB;
constexpr size_t WS_XN = 316 * MiB;
constexpr size_t WS_BIG = 381 * MiB;
constexpr size_t WS_ACT = WS_BIG;
constexpr size_t WS_Q = WS_BIG, WS_K = WS_BIG + 65 * MiB, WS_V = WS_BIG + 130 * MiB, WS_OG = WS_BIG + 195 * MiB;
constexpr size_t WS_ND = WS_BIG + 260 * MiB;
constexpr size_t WS_LOGF = WS_BIG + 262 * MiB;
constexpr size_t WS_AO = WS_BIG + 270 * MiB;
constexpr size_t WS_T0 = WS_BIG + 266 * MiB;
constexpr size_t WS_THR = WS_BIG + 265 * MiB;
constexpr size_t WS_RQ = WS_BIG, WS_RK = WS_BIG + 65 * MiB, WS_RV = WS_BIG + 130 * MiB, WS_RG = WS_BIG + 260 * MiB, WS_RO = WS_BIG + 390 * MiB;
constexpr size_t WS_U = WS_BIG + 520 * MiB;
constexpr size_t WS_SSQP = WS_BIG + 552 * MiB;
constexpr size_t WS_SSQS = WS_BIG + 554 * MiB;
constexpr size_t WS_END = WS_BIG + 555 * MiB;
constexpr size_t O_YP = 0, O_YS = O_YP + (size_t)MP * DM, O_FKP = O_YS + (size_t)MS * DM, O_FVP = O_FKP + 2 * (size_t)MP * DM, O_FLP = O_FVP + 2 * (size_t)MP * DM,
                 O_RP = O_FLP + 2 * (size_t)MP * 16, O_FKS = O_RP + 2 * (size_t)NBATCH * 8 * 128 * 256, O_FVS = O_FKS + 2 * (size_t)MS * DM, O_FLS = O_FVS + 2 * (size_t)MS * DM,
                 O_RS = O_FLS + 2 * (size_t)MS * 16, O_END = O_RS + 2 * (size_t)DEC_B * 8 * 128 * 256;
static_assert(O_END == 180895744, "output size");
constexpr int CW_BAR = 4096;
constexpr int RING_OFF = 0, RING_BYTES = 131072;
constexpr int LDSCTL_OFF = RING_BYTES, MISC_OFF = LDSCTL_OFF + 320, GL_OFF = LDSCTL_OFF + 1024, RSB_OFF = LDSCTL_OFF + 2048;
constexpr int LDS_BYTES = 147456;
__device__ __forceinline__ float wave_sum(float v, int lane) {
#pragma unroll
    for (int o = 1; o < 64; o <<= 1) v += bperm(v, lane ^ o);
    return v;
}
__device__ __forceinline__ float wave_max(float v, int lane) {
#pragma unroll
    for (int o = 1; o < 64; o <<= 1) v = fmaxf(v, bperm(v, lane ^ o));
    return v;
}
template <bool PK = true>
__device__ __forceinline__ void wt_item(const float* W, int ldw, int K, bf16* WT, int k0, int n0, int srccol0, LAS float* scr, int lane, const float* gk = nullptr) {
#pragma unroll 8
    for (int i = 0; i < 32; ++i) { const int kk = 2 * i + (lane >> 5); const float w = W[(size_t)(k0 + kk) * ldw + srccol0 + (lane & 31)]; scr[kk * 33 + (lane & 31)] = gk ? w * gk[k0 + kk] : w; }
    LDS_WAIT(); asm volatile("" ::: "memory");
    const int c = lane & 7;
#pragma unroll
    for (int j = 0; j < 4; ++j) { const int n = (lane >> 3) + 8 * j; const LAS float* s = scr + (8 * c) * 33 + n;
        v4u o; o.x = pk2(s[0 * 33], s[1 * 33]); o.y = pk2(s[2 * 33], s[3 * 33]); o.z = pk2(s[4 * 33], s[5 * 33]); o.w = pk2(s[6 * 33], s[7 * 33]);
        *(GAS v4u*)(WT + (PK ? pg8::pk_elem(pg8::pk_slot(n0 + n), k0 + 8 * c, K >> 6) : (size_t)(n0 + n) * K + k0 + 8 * c)) = o; }
    LDS_WAIT(); asm volatile("" ::: "memory");
}
__device__ __forceinline__ int src_ffn_in(int n0) { const int pn = n0 >> 8, sel = (n0 >> 7) & 1, j0 = n0 & 127; return sel * FF + 128 * pn + j0; }
__device__ __forceinline__ int src_fox_in(int n0) { const int pn = n0 >> 8, bj = (n0 >> 7) & 1, wc = (n0 >> 5) & 3; return (pn >> 2) * 1024 + (4 * (pn & 3) + wc) * 64 + 32 * bj; }
__device__ __forceinline__ int src_ret_in(int n0) { const int pn = n0 >> 8; if (pn >= 8) return n0; const int bj = (n0 >> 7) & 1, wc = (n0 >> 5) & 3; return (pn >> 2) * 1024 + (2 * (pn & 3) + (wc >> 1)) * 128 + 64 * bj + 32 * (wc & 1); }

struct Ptrs {
    const float *x_prompt, *x_sample, *cache_k, *cache_v, *cache_lf, *state_ret, *norm_gains, *w_ffn_in, *w_ffn_out, *fox_w_in, *fox_b_f, *fox_qg, *fox_kg, *fox_w_out, *ret_w_in, *ret_w_out, *final_gain;
    float* out; unsigned char* ws;
};

__device__ __forceinline__ void p0_prologue(const Ptrs& P, LAS unsigned char* lds, int gw, int NGW, int wave, int lane) {
    LAS float* scr = (LAS float*)(lds + RING_OFF + wave * 16384);
    constexpr int I_FI = 16 * 176, I_FO = 44 * 32, I_XI = 16 * 128, I_XO = 16 * 32, I_RI = 16 * 192, I_RO = 32 * 32;
    constexpr int T_FI = 8 * I_FI, T_FO = T_FI + 8 * I_FO, T_XI = T_FO + 2 * I_XI, T_XO = T_XI + 2 * I_XO, T_RI = T_XO + 2 * I_RI, T_RO = T_RI + 2 * I_RO;
    for (int it = gw; it < T_RO; it += NGW) {
        if (it < T_FI) { const int w = it / I_FI, r = it % I_FI, kb = r / 176, nb = r % 176;
            wt_item(P.w_ffn_in + (size_t)w * 1024 * 5632, 5632, 1024, (bf16*)(P.ws + WS_WFI + w * WFI_STRIDE), 64 * kb, 32 * nb, src_ffn_in(32 * nb), scr, lane, P.norm_gains + (size_t)((w >> 1) * 3 + ((w & 1) ? 2 : 0)) * DM); }
        else if (it < T_FO) { const int q = it - T_FI, w = q / I_FO, r = q % I_FO, kb = r / 32, nb = r % 32;
            wt_item(P.w_ffn_out + (size_t)w * 2816 * 1024, 1024, 2816, (bf16*)(P.ws + WS_WFO + w * WFO_STRIDE), 64 * kb, 32 * nb, 32 * nb, scr, lane); }
        else if (it < T_XI) { const int q = it - T_FO, w = q / I_XI, r = q % I_XI, kb = r / 128, nb = r % 128;
            wt_item(P.fox_w_in + (size_t)w * 1024 * FOX_COLS, FOX_COLS, 1024, (bf16*)(P.ws + WS_WXI + w * WXI_STRIDE), 64 * kb, 32 * nb, src_fox_in(32 * nb), scr, lane, P.norm_gains + (size_t)((2 * w) * 3 + 1) * DM); }
        else if (it < T_XO) { const int q = it - T_XI, w = q / I_XO, r = q % I_XO, kb = r / 32, nb = r % 32;
            wt_item(P.fox_w_out + (size_t)w * 1024 * 1024, 1024, 1024, (bf16*)(P.ws + WS_WXO + w * WXO_STRIDE), 64 * kb, 32 * nb, 32 * nb, scr, lane); }
        else if (it < T_RI) { const int q = it - T_XO, w = q / I_RI, r = q % I_RI, kb = r / 192, nb = r % 192;
            wt_item(P.ret_w_in + (size_t)w * 1024 * 6144, 6144, 1024, (bf16*)(P.ws + WS_WRI + w * WRI_STRIDE), 64 * kb, 32 * nb, src_ret_in(32 * nb), scr, lane, P.norm_gains + (size_t)((2 * w + 1) * 3 + 1) * DM); }
        else { const int q = it - T_RI, w = q / I_RO, r = q % I_RO, kb = r / 32, nb = r % 32;
            wt_item(P.ret_w_out + (size_t)w * 2048 * 1024, 1024, 2048, (bf16*)(P.ws + WS_WRO + w * WRO_STRIDE), 64 * kb, 32 * nb, 32 * nb, scr, lane); }
    }
    { bf16* Xb = (bf16*)(P.ws + WS_X);
      for (int m = gw; m < M; m += NGW) {
        const GAS f32x4* xr = (const GAS f32x4*)((m < MP) ? P.x_prompt + (size_t)m * DM : P.x_sample + (size_t)(m - MP) * DM) + lane;
        float s2 = 0.f;
#pragma unroll
        for (int j = 0; j < 4; ++j) { const f32x4 v = xr[64 * j]; *(GAS unsigned long long*)(Xb + pg8::pk_elem(m, 4 * lane + 256 * j, 16)) = (unsigned long long)pk2(v.x, v.y) | ((unsigned long long)pk2(v.z, v.w) << 32); s2 += (v.x * v.x + v.y * v.y) + (v.z * v.z + v.w * v.w); }
        s2 = wave_sum(s2, lane);
        if (m < MP) { if (lane < 16) ((float*)(P.ws + WS_SSQP))[(size_t)m * 16 + lane] = lane == 0 ? s2 : 0.f; } else ((float*)(P.ws + WS_SSQS))[(size_t)(m - MP) * 64 + lane] = lane == 0 ? s2 : 0.f; } }
    float* WF = (float*)(P.ws + WS_WF);
    for (int i = gw * 64 + lane; i < 2 * 16 * 1024; i += NGW * 64) { const int jl = i >> 14, h = (i >> 10) & 15, k = i & 1023; WF[i] = P.fox_w_in[((size_t)jl * 1024 + k) * FOX_COLS + 4096 + h]; }
}

__device__ __forceinline__ float log_sigmoid(float z) { return fminf(z, 0.f) - log1pf(__expf(-fabsf(z))); }

__device__ __forceinline__ void forget_phase(const bf16* Xb, const float* gain, const float* WFl, const float* bfp, float* LOGF, float* outP, float* outS,
                                             LAS unsigned char* lds, int gw, int NGW, int tid, int lane) {
    LAS float* wl = (LAS float*)(lds + RING_OFF);
    for (int i = tid; i < 4096; i += NWAVES * 64) ((LAS f32x4*)wl)[i] = ((const f32x4*)WFl)[i];
    __syncthreads();
    f32x4 g[4];
#pragma unroll
    for (int j = 0; j < 4; ++j) g[j] = ((const f32x4*)gain)[lane + 64 * j];
    const bool b5 = (lane & 32) != 0, b4 = (lane & 16) != 0;
    unsigned long long xn[2][4];
#define FORGET_FETCH(m0_) do { _Pragma("unroll") for (int k = 0; k < 2; ++k) { const int m_ = (m0_) + k * NGW; const int mr = (m_ < M) ? m_ : 0; \
        _Pragma("unroll") for (int j = 0; j < 4; ++j) xn[k][j] = *(const GAS unsigned long long*)(Xb + pg8::pk_elem(mr, 4 * lane + 256 * j, 16)); } } while (0)
    FORGET_FETCH(gw);
    for (int m0 = gw; m0 < M; m0 += 2 * NGW) {
        f32x4 v[2][4]; float s2[2] = {0.f, 0.f};
#pragma unroll
        for (int k = 0; k < 2; ++k)
#pragma unroll
            for (int j = 0; j < 4; ++j) { const unsigned long long w = xn[k][j]; const unsigned lo = (unsigned)w, hh = (unsigned)(w >> 32);
                v[k][j] = (f32x4){__uint_as_float(lo << 16), __uint_as_float(lo & 0xffff0000u), __uint_as_float(hh << 16), __uint_as_float(hh & 0xffff0000u)};
                s2[k] += (v[k][j].x * v[k][j].x + v[k][j].y * v[k][j].y) + (v[k][j].z * v[k][j].z + v[k][j].w * v[k][j].w); }
        if (m0 + 2 * NGW < M) FORGET_FETCH(m0 + 2 * NGW);
#pragma unroll
        for (int o = 1; o < 64; o <<= 1) { s2[0] += bperm(s2[0], lane ^ o); s2[1] += bperm(s2[1], lane ^ o); }
#pragma unroll
        for (int k = 0; k < 2; ++k) { const float rstd = __builtin_amdgcn_rsqf(s2[k] * (1.f / DM) + RMS_EPS);
#pragma unroll
            for (int j = 0; j < 4; ++j) v[k][j] = v[k][j] * rstd * g[j]; }
#pragma unroll 1
        for (int h0 = 0; h0 < 16; h0 += 4) {
            float p[2][4];
#pragma unroll
            for (int q = 0; q < 4; ++q) { p[0][q] = 0.f; p[1][q] = 0.f;
#pragma unroll
                for (int j = 0; j < 4; ++j) { const f32x4 w = ((const LAS f32x4*)(wl + (h0 + q) * 1024))[lane + 64 * j];
#pragma unroll
                    for (int k = 0; k < 2; ++k) p[k][q] += (v[k][j].x * w.x + v[k][j].y * w.y) + (v[k][j].z * w.z + v[k][j].w * w.w); } }
#pragma unroll
            for (int k = 0; k < 2; ++k) {
                const float s0 = b5 ? p[k][0] : p[k][2], s1 = b5 ? p[k][1] : p[k][3], k0 = b5 ? p[k][2] : p[k][0], k1 = b5 ? p[k][3] : p[k][1];
                const float q0 = k0 + bperm(s0, lane ^ 32), q1 = k1 + bperm(s1, lane ^ 32);
                float r = (b4 ? q1 : q0) + bperm(b4 ? q0 : q1, lane ^ 16);
                r += bperm(r, lane ^ 8); r += bperm(r, lane ^ 4); r += bperm(r, lane ^ 2); r += bperm(r, lane ^ 1);
                if ((lane & 15) == 0) {
                    const int hd = h0 + (lane >> 4); const int m = m0 + k * NGW;
                    if (m < M) { const float lf = log_sigmoid(r + bfp[hd]); LOGF[(size_t)m * 16 + hd] = lf;
                        if (m < MP) outP[(size_t)m * 16 + hd] = lf; else outS[(size_t)(m - MP) * 16 + hd] = lf; } }
            }
        }
    }
}
#undef FORGET_FETCH
__device__ __forceinline__ void final_norm_phase(const bf16* X, const float* gain, float* yP, float* yS, int gw, int NGW, int lane) {
    f32x4 g[4];
#pragma unroll
    for (int j = 0; j < 4; ++j) g[j] = ((const f32x4*)gain)[lane + 64 * j];
    unsigned long long xn[4];
#pragma unroll
    for (int j = 0; j < 4; ++j) xn[j] = *(const GAS unsigned long long*)(X + pg8::pk_elem(gw < M ? gw : 0, 4 * lane + 256 * j, 16));
    for (int m = gw; m < M; m += NGW) {
        f32x4 v[4]; float s2 = 0.f; unsigned long long xc[4];
#pragma unroll
        for (int j = 0; j < 4; ++j) xc[j] = xn[j];
        if (m + NGW < M) {
#pragma unroll
            for (int j = 0; j < 4; ++j) xn[j] = *(const GAS unsigned long long*)(X + pg8::pk_elem(m + NGW, 4 * lane + 256 * j, 16)); }
#pragma unroll
        for (int j = 0; j < 4; ++j) { const unsigned long long w = xc[j]; const unsigned lo = (unsigned)w, hh = (unsigned)(w >> 32);
            v[j] = (f32x4){__uint_as_float(lo << 16), __uint_as_float(lo & 0xffff0000u), __uint_as_float(hh << 16), __uint_as_float(hh & 0xffff0000u)};
            s2 += (v[j].x * v[j].x + v[j].y * v[j].y) + (v[j].z * v[j].z + v[j].w * v[j].w); }
        const float rstd = 1.0f / sqrtf(wave_sum(s2, lane) * (1.f / DM) + RMS_EPS);
        GAS f32x4* o = (GAS f32x4*)((m < MP ? yP + (size_t)m * DM : yS + (size_t)(m - MP) * DM)) + lane;
#pragma unroll
        for (int j = 0; j < 4; ++j) __builtin_nontemporal_store(v[j] * rstd * g[j], (f32x4*)&o[64 * j]);
    }
}
__device__ __forceinline__ void cumsum_unit(const float* LOGF, float* ND, int bh, LAS unsigned char* lds, int tid, int wave, int lane, float margin, int* T0) {
    const int b = bh >> 4, h = bh & 15; LAS float* wt = (LAS float*)(lds + RING_OFF);
    LAS float* te = (LAS float*)(lds + RING_OFF + 1024); LAS float* q0 = (LAS float*)(lds + RING_OFF + 2048);
    const float* src = LOGF + ((size_t)b * SEQ + (size_t)tid * 32) * 16 + h;
    float v[32]; float run = 0.f;
#pragma unroll
    for (int i = 0; i < 32; ++i) { run += src[(size_t)i * 16]; v[i] = run; }
    float inc = run;
#pragma unroll
    for (int o = 1; o < 64; o <<= 1) { const float t = bperm(inc, lane - o); if (lane >= o) inc += t; }
    if (lane == 63) wt[wave] = inc;
    __syncthreads();
    float base = inc - run;
    for (int w = 0; w < wave; ++w) base += wt[w];
    float* dst = ND + (size_t)bh * SEQ + (size_t)tid * 32;
#pragma unroll
    for (int i = 0; i < 32; i += 4) { f32x4 o; o.x = -LOG2E * (base + v[i]); o.y = -LOG2E * (base + v[i + 1]); o.z = -LOG2E * (base + v[i + 2]); o.w = -LOG2E * (base + v[i + 3]); *(f32x4*)(dst + i) = o; }
    if (tid & 1) te[tid >> 1] = -LOG2E * (base + v[31]);
    if ((tid & 7) == 0) q0[tid >> 3] = -LOG2E * (base + v[0]);
    __syncthreads();
    { const int qb = tid >> 3, part = tid & 7, ntf = 4 * qb + 4; const float thr = q0[qb] - margin; int cnt = 0;
#pragma unroll
      for (int k = 0; k < 32; ++k) { const int t = 32 * part + k; cnt += ((t < ntf) && (te[t] <= thr)) ? 1 : 0; }
      cnt += __builtin_amdgcn_ds_bpermute((lane ^ 1) << 2, cnt); cnt += __builtin_amdgcn_ds_bpermute((lane ^ 2) << 2, cnt); cnt += __builtin_amdgcn_ds_bpermute((lane ^ 4) << 2, cnt);
      int t0 = cnt & ~1; if (t0 > ntf - 4) t0 = ntf - 4;
      if (part == 0) T0[bh * 64 + qb] = t0; }
    __syncthreads();
}

template <bool PKA, bool PKB>
__device__ __forceinline__ void small_gemm_resid(const bf16* A, const bf16* Bt, int K, bf16* X, float s, int unit, LAS unsigned char* lds, float* SSQS) {
    int tid_ = threadIdx.x; asm volatile("" : "+v"(tid_)); const int tid = tid_, lane = tid & 63, wid = __builtin_amdgcn_readfirstlane(tid >> 6);
    const int row0 = MP + 64 * (unit >> 5), col0 = 32 * (unit & 31), fr = lane & 15, fq = lane >> 4;
    f32x4 acc[4][2];
#pragma unroll
    for (int rt = 0; rt < 4; ++rt)
#pragma unroll
        for (int ct = 0; ct < 2; ++ct) acc[rt][ct] = (f32x4){0.f, 0.f, 0.f, 0.f};
    const int kw = K >> 3;
    unsigned short xin[4];
#pragma unroll
    for (int q = 0; q < 4; ++q) { const int idx = tid + 512 * q, l2 = idx & 63, r = (idx >> 6) & 3, ct = (idx >> 8) & 1, rt = idx >> 9;
        xin[q] = X[pg8::pk_elem(row0 + 16 * rt + 4 * (l2 >> 4) + r, col0 + 16 * ct + (l2 & 15), 16)]; }
    const bf16* ap = A + (size_t)(row0 + fr) * K + wid * kw + 8 * fq;
    const bf16* bp = Bt + (size_t)(col0 + fr) * K + wid * kw + 8 * fq;
    for (int ks = 0; ks < kw; ks += 128) {
        bf16x8 a[4][4], b[4][2];
#pragma unroll
        for (int t = 0; t < 4; ++t) if (ks + 32 * t < kw) {
#pragma unroll
            for (int rt = 0; rt < 4; ++rt) a[t][rt] = PKA ? *(const bf16x8*)(A + pg8::pk_elem(row0 + fr + 16 * rt, wid * kw + 8 * fq + ks + 32 * t, K >> 6)) : *(const bf16x8*)(ap + (size_t)(16 * rt) * K + ks + 32 * t);
#pragma unroll
            for (int ct = 0; ct < 2; ++ct) b[t][ct] = PKB ? *(const bf16x8*)(Bt + pg8::pk_elem(pg8::pk_slot(col0 + fr + 16 * ct), wid * kw + 8 * fq + ks + 32 * t, K >> 6)) : *(const bf16x8*)(bp + (size_t)(16 * ct) * K + ks + 32 * t); }
#pragma unroll
        for (int t = 0; t < 4; ++t) if (ks + 32 * t < kw) {
#pragma unroll
            for (int rt = 0; rt < 4; ++rt)
#pragma unroll
                for (int ct = 0; ct < 2; ++ct) acc[rt][ct] = __builtin_amdgcn_mfma_f32_16x16x32_bf16(a[t][rt], b[t][ct], acc[rt][ct], 0, 0, 0); }
    }
    LAS float* red = (LAS float*)(lds + RING_OFF);
#pragma unroll
    for (int rt = 0; rt < 4; ++rt)
#pragma unroll
        for (int ct = 0; ct < 2; ++ct)
#pragma unroll
            for (int r = 0; r < 4; ++r) red[((wid * 8 + rt * 2 + ct) * 4 + r) * 64 + lane] = acc[rt][ct][r];
    __syncthreads();
#pragma unroll
    for (int q = 0; q < 4; ++q) { const int idx = tid + 512 * q, l2 = idx & 63, r = (idx >> 6) & 3, ct = (idx >> 8) & 1, rt = idx >> 9;
        float sum = 0.f;
#pragma unroll
        for (int w = 0; w < 8; ++w) sum += red[w * 2048 + idx];
        const size_t o = pg8::pk_elem(row0 + 16 * rt + 4 * (l2 >> 4) + r, col0 + 16 * ct + (l2 & 15), 16);
        const float v = __uint_as_float((unsigned)xin[q] << 16) + s * sum; X[o] = (bf16)f2bf(v);
        float ss = v * v; ss += bperm(ss, lane ^ 1); ss += bperm(ss, lane ^ 2); ss += bperm(ss, lane ^ 4); ss += bperm(ss, lane ^ 8);
        if ((l2 & 15) == 0) SSQS[(size_t)(row0 - MP + 16 * rt + 4 * (l2 >> 4) + r) * 64 + 2 * (unit & 31) + ct] = ss; }
    __syncthreads();
}

__device__ __forceinline__ void kv_out_chunk(const bf16* Kb, const bf16* Vb, float* kP, float* vP, float* kS, float* vS, int c) {
    int tid_ = threadIdx.x; asm volatile("" : "+v"(tid_)); const int tid = tid_;
#pragma unroll 1
    for (int base = 0; base < 65 * 512; base += 22 * 512) {
        unsigned long long k[22], v[22];
#pragma unroll
        for (int u = 0; u < 22; ++u) { const int g = base + u * 512 + tid; const int gc = g < 65 * 512 ? g : 65 * 512 - 1; const size_t off = (size_t)(130 * c + (gc >> 8)) * DM + (gc & 255) * 4; k[u] = *(const unsigned long long*)(Kb + off); v[u] = *(const unsigned long long*)(Vb + off); }
        asm volatile("" ::: "memory");
#pragma unroll
        for (int u = 0; u < 22; ++u) { if (base + u * 512 >= 65 * 512) break; const int g = base + u * 512 + tid; const int row = 130 * c + (g >> 8); const size_t off = (size_t)row * DM + (g & 255) * 4;
            float* ko = (row < MP) ? kP + off : kS + (off - (size_t)MP * DM); float* vo = (row < MP) ? vP + off : vS + (off - (size_t)MP * DM);
            const unsigned k0 = (unsigned)k[u], k1 = (unsigned)(k[u] >> 32), v0 = (unsigned)v[u], v1 = (unsigned)(v[u] >> 32);
            __builtin_nontemporal_store((f32x4){__uint_as_float(k0 << 16), __uint_as_float(k0 & 0xffff0000u), __uint_as_float(k1 << 16), __uint_as_float(k1 & 0xffff0000u)}, (f32x4*)ko);
            __builtin_nontemporal_store((f32x4){__uint_as_float(v0 << 16), __uint_as_float(v0 & 0xffff0000u), __uint_as_float(v1 << 16), __uint_as_float(v1 & 0xffff0000u)}, (f32x4*)vo); }
    }
}
namespace smp {
typedef short bf16x8 __attribute__((ext_vector_type(8)));
typedef float f32x16 __attribute__((ext_vector_type(16)));
constexpr int L_ND = 0;
constexpr int L_WT = 8448;
constexpr int L_LP = 8704;
constexpr int L_OP = 16384;
constexpr int L_END = L_OP + 65536;
__device__ __forceinline__ int crow(int r, int hi) { return (r & 3) + 8 * (r >> 2) + 4 * hi; }
__device__ __forceinline__ bf16x8 cvt8(const f32x4 a, const f32x4 b) { const u32x4q w = {pkq(a[0], a[1]), pkq(a[2], a[3]), pkq(b[0], b[1]), pkq(b[2], b[3])}; return __builtin_bit_cast(bf16x8, w); }

__device__ __forceinline__ void unit(int jl, int b, int h, const float* kcache, const float* vcache, const float* lfcache, const float* LOGF,
                                     const bf16* Q, const bf16* Kb, const bf16* Vb, const bf16* OG, bf16* OUT, LAS unsigned char* lds) {
    int tid_ = threadIdx.x; asm volatile("" : "+v"(tid_)); const int tid = tid_, lane = tid & 63, wid = __builtin_amdgcn_readfirstlane(tid >> 6);
    const int r32 = lane & 31, hi = lane >> 5;
    LAS float* nd = (LAS float*)(lds + L_ND); LAS float* wt = (LAS float*)(lds + L_WT); LAS float* lp = (LAS float*)(lds + L_LP); LAS float* op = (LAS float*)(lds + L_OP);
    const size_t cb = ((size_t)jl * DEC_B + b) * PAST;
    {
        float v[5]; float run = 0.f;
#pragma unroll
        for (int i = 0; i < 5; ++i) { const int j = tid * 5 + i; float lf = 0.f;
            if (j < PAST) lf = lfcache[(cb + j) * 16 + h]; else if (j < PAST + DEC_S) lf = LOGF[(size_t)(MP + b * DEC_S + (j - PAST)) * 16 + h];
            run += lf; v[i] = run; }
        float inc = run;
#pragma unroll
        for (int o = 1; o < 64; o <<= 1) { const float t = bperm(inc, lane - o); if (lane >= o) inc += t; }
        if (lane == 63) wt[wid] = inc;
        __syncthreads();
        float base = inc - run;
        for (int w = 0; w < wid; ++w) base += wt[w];
#pragma unroll
        for (int i = 0; i < 5; ++i) { const int j = tid * 5 + i; if (j < PAST + DEC_S) nd[j] = -LOG2E * (base + v[i]); }
        __syncthreads();
    }
    const size_t qrow = (size_t)(MP + b * DEC_S + r32) * DM + h * 64;
    bf16x8 qf[4];
#pragma unroll
    for (int s = 0; s < 4; ++s) qf[s] = *(const bf16x8*)(Q + qrow + 16 * s + 8 * hi);
    const float ndi = nd[PAST + r32];
    f32x16 o0 = {}, o1 = {}; float lsum = 0.f;
#define SMP_SCORES(T_, MASK_) \
        f32x16 S; \
        _Pragma("unroll") for (int r = 0; r < 16; ++r) S[r] = -ndi; \
        _Pragma("unroll") for (int s = 0; s < 4; ++s) S = __builtin_amdgcn_mfma_f32_32x32x16_bf16(ka[s], qf[s], S, 0, 0, 0); \
        _Pragma("unroll") for (int g = 0; g < 4; ++g) { const f32x4 bq = *(const LAS f32x4*)(nd + (T_) * 32 + 8 * g + 4 * hi); \
            _Pragma("unroll") for (int e = 0; e < 4; ++e) { float x = S[4 * g + e] + bq[e]; if ((MASK_) && (8 * g + 4 * hi + e) > r32) x = -INFINITY; const float p = __builtin_amdgcn_exp2f(x); S[4 * g + e] = p; lsum += p; } } \
        const bf16x8 pa0 = cvt8((f32x4){S[0], S[1], S[2], S[3]}, (f32x4){S[4], S[5], S[6], S[7]}), pa1 = cvt8((f32x4){S[8], S[9], S[10], S[11]}, (f32x4){S[12], S[13], S[14], S[15]});
    for (int T = wid; T < 64; T += NWAVES) {
        const float* kp = kcache + ((cb + (size_t)T * 32 + r32) * 16 + h) * 64 + 8 * hi;
        f32x4 kr[8]; float vr[2][2][8];
#pragma unroll
        for (int s = 0; s < 4; ++s) { kr[2 * s] = *(const f32x4*)(kp + 16 * s); kr[2 * s + 1] = *(const f32x4*)(kp + 16 * s + 4); }
#pragma unroll
        for (int sp = 0; sp < 2; ++sp)
#pragma unroll
            for (int db = 0; db < 2; ++db)
#pragma unroll
                for (int jj = 0; jj < 8; ++jj) vr[sp][db][jj] = vcache[((cb + (size_t)T * 32 + 16 * sp + 8 * (jj >> 2) + 4 * hi + (jj & 3)) * 16 + h) * 64 + 32 * db + r32];
        bf16x8 ka[4];
#pragma unroll
        for (int s = 0; s < 4; ++s) ka[s] = cvt8(kr[2 * s], kr[2 * s + 1]);
        SMP_SCORES(T, false)
#pragma unroll
        for (int sp = 0; sp < 2; ++sp) { const bf16x8 pa = sp == 0 ? pa0 : pa1;
            const bf16x8 v0 = cvt8((f32x4){vr[sp][0][0], vr[sp][0][1], vr[sp][0][2], vr[sp][0][3]}, (f32x4){vr[sp][0][4], vr[sp][0][5], vr[sp][0][6], vr[sp][0][7]});
            const bf16x8 v1 = cvt8((f32x4){vr[sp][1][0], vr[sp][1][1], vr[sp][1][2], vr[sp][1][3]}, (f32x4){vr[sp][1][4], vr[sp][1][5], vr[sp][1][6], vr[sp][1][7]});
            o0 = __builtin_amdgcn_mfma_f32_32x32x16_bf16(pa, v0, o0, 0, 0, 0); o1 = __builtin_amdgcn_mfma_f32_32x32x16_bf16(pa, v1, o1, 0, 0, 0); }
    }
    if (wid == 0) {
        const int T = 64;
        const bf16* kp = Kb + (size_t)(MP + b * DEC_S + r32) * DM + h * 64 + 8 * hi;
        bf16x8 ka[4];
#pragma unroll
        for (int s = 0; s < 4; ++s) ka[s] = *(const bf16x8*)(kp + 16 * s);
        bf16x8 vf[2][2];
#pragma unroll
        for (int sp = 0; sp < 2; ++sp)
#pragma unroll
            for (int db = 0; db < 2; ++db) { bf16x8 t;
#pragma unroll
                for (int jj = 0; jj < 8; ++jj) t[jj] = (short)Vb[(size_t)(MP + b * DEC_S + 16 * sp + 8 * (jj >> 2) + 4 * hi + (jj & 3)) * DM + h * 64 + 32 * db + r32];
                vf[sp][db] = t; }
        SMP_SCORES(T, true)
        o0 = __builtin_amdgcn_mfma_f32_32x32x16_bf16(pa0, vf[0][0], o0, 0, 0, 0); o1 = __builtin_amdgcn_mfma_f32_32x32x16_bf16(pa0, vf[0][1], o1, 0, 0, 0);
        o0 = __builtin_amdgcn_mfma_f32_32x32x16_bf16(pa1, vf[1][0], o0, 0, 0, 0); o1 = __builtin_amdgcn_mfma_f32_32x32x16_bf16(pa1, vf[1][1], o1, 0, 0, 0);
    }
#undef SMP_SCORES
    lsum += bperm(lsum, lane ^ 32);
    if (hi == 0) lp[wid * 32 + r32] = lsum;
#pragma unroll
    for (int r = 0; r < 16; ++r) { op[((wid * 2 + 0) * 16 + r) * 64 + lane] = o0[r]; op[((wid * 2 + 1) * 16 + r) * 64 + lane] = o1[r]; }
    __syncthreads();
    {
        const int i = tid >> 4, d0 = 4 * (tid & 15);
        float l = 0.f;
#pragma unroll
        for (int w = 0; w < 8; ++w) l += lp[w * 32 + i];
        const float rl = 1.0f / l;
        const int hi2 = (i >> 2) & 1, r = (i & 3) + 4 * (i >> 3);
        float acc[4] = {0.f, 0.f, 0.f, 0.f};
#pragma unroll
        for (int w = 0; w < 8; ++w)
#pragma unroll
            for (int e = 0; e < 4; ++e) { const int d = d0 + e; acc[e] += op[((w * 2 + (d >> 5)) * 16 + r) * 64 + (d & 31) + 32 * hi2]; }
        const size_t orow = (size_t)(MP + b * DEC_S + i) * DM + h * 64 + d0;
        const unsigned long long gw8 = *(const unsigned long long*)(OG + orow);
        const unsigned g0 = (unsigned)gw8, g1 = (unsigned)(gw8 >> 32);
        const float y0 = acc[0] * rl * __uint_as_float(g0 << 16), y1 = acc[1] * rl * __uint_as_float(g0 & 0xffff0000u), y2 = acc[2] * rl * __uint_as_float(g1 << 16), y3 = acc[3] * rl * __uint_as_float(g1 & 0xffff0000u);
        *(unsigned long long*)(OUT + orow) = (unsigned long long)pkq(y0, y1) | ((unsigned long long)pkq(y2, y3) << 32);
    }
    __syncthreads();
}
}

namespace ret {
typedef short bf16x8 __attribute__((ext_vector_type(8)));
typedef short s16x4 __attribute__((ext_vector_type(4)));
typedef float f32x16 __attribute__((ext_vector_type(16)));
constexpr int KS = 272, KDS = 320, VS = 576, OSS = 528;
constexpr int L_QD = 0, L_K = 17408, L_KD = 34816, L_V = 55296, L_OS = 92160, L_END = 125952, L_XF = 131072 + 2048;
constexpr int GCH = 16;
__device__ __forceinline__ int crow(int r, int hi) { return (r & 3) + 8 * (r >> 2) + 4 * hi; }
__device__ __forceinline__ s16x4 trd(const LAS unsigned char* p) { return __builtin_bit_cast(s16x4, __builtin_amdgcn_ds_read_tr16_b64_v4i16((LAS v4i16q*)p)); }
__device__ __forceinline__ bf16x8 cat(s16x4 a, s16x4 b) { return (bf16x8){a[0], a[1], a[2], a[3], b[0], b[1], b[2], b[3]}; }
__device__ __forceinline__ u32x4q scale8(u32x4q w, float f) { u32x4q o;
#pragma unroll
    for (int e = 0; e < 4; ++e) o[e] = pkq(__uint_as_float(w[e] << 16) * f, __uint_as_float(w[e] & 0xffff0000u) * f);
    return o; }
__device__ __forceinline__ bf16x8 pack8(const f32x16& x, int b) { const u32x4q w = {pkq(x[b], x[b + 1]), pkq(x[b + 2], x[b + 3]), pkq(x[b + 4], x[b + 5]), pkq(x[b + 6], x[b + 7])}; return __builtin_bit_cast(bf16x8, w); }

template <bool WITH_OUT>
__device__ __forceinline__ void unit(LAS unsigned char* lds, int rowbase, int nch, int n, int h, float lg2, const bf16* RQ, const bf16* RK, const bf16* RV, const bf16* RG, bf16* RO,
                                     const float* Sin, float* Sout) {
    int tid_ = threadIdx.x; asm volatile("" : "+v"(tid_)); const int tid = tid_, lane = tid & 63, w = __builtin_amdgcn_readfirstlane(tid >> 6);
    const int r32 = lane & 31, hi = lane >> 5, li = lane & 15, grp = (lane >> 4) & 1;
    const int qrow0 = tid >> 4, qch = tid & 15, vrow0 = tid >> 5, vch = tid & 31;
    const float sdec = __builtin_amdgcn_exp2f(lg2 * (float)n);
    f32x16 S[4];
#pragma unroll
    for (int d = 0; d < 4; ++d)
#pragma unroll
        for (int r = 0; r < 16; ++r) S[d][r] = Sin ? Sin[(size_t)(32 * d + crow(r, hi)) * 256 + 32 * w + r32] : 0.f;
    const int xjb = (w >> 1) & 1, xib = w & 1;
    const int gtok = tid >> 3, gseg = tid & 7;
    u32x4q rq[2] = {{0u, 0u, 0u, 0u}, {0u, 0u, 0u, 0u}}, rk[2], rv[4];
#define RET_GLOAD(c_) do { const size_t tb_ = (size_t)rowbase + (size_t)(c_) * 64; \
        _Pragma("unroll") for (int u = 0; u < 2; ++u) { const int row_ = qrow0 + 32 * u; const bool ok_ = row_ < n; \
            rk[u] = ok_ ? *(const u32x4q*)(RK + (tb_ + row_) * 1024 + h * 128 + qch * 8) : (u32x4q){0u, 0u, 0u, 0u}; \
            if (WITH_OUT) rq[u] = ok_ ? *(const u32x4q*)(RQ + (tb_ + row_) * 1024 + h * 128 + qch * 8) : (u32x4q){0u, 0u, 0u, 0u}; } \
        _Pragma("unroll") for (int u = 0; u < 4; ++u) { const int row_ = vrow0 + 16 * u; \
            rv[u] = (row_ < n) ? *(const u32x4q*)(RV + (tb_ + row_) * 2048 + h * 256 + vch * 8) : (u32x4q){0u, 0u, 0u, 0u}; } } while (0)
#define RET_GN(cc_) do { float v[32]; float sm = 0.f; \
        _Pragma("unroll") for (int u = 0; u < 4; ++u) { const u32x4q o = *(const LAS u32x4q*)(lds + L_OS + gtok * OSS + gseg * 64 + 16 * u); \
            _Pragma("unroll") for (int e = 0; e < 4; ++e) { v[8 * u + 2 * e] = __uint_as_float(o[e] << 16); v[8 * u + 2 * e + 1] = __uint_as_float(o[e] & 0xffff0000u); sm += v[8 * u + 2 * e] + v[8 * u + 2 * e + 1]; } } \
        sm += bperm(sm, lane ^ 1); sm += bperm(sm, lane ^ 2); sm += bperm(sm, lane ^ 4); \
        const float mu = sm * (1.f / 256.f); float qv = 0.f; \
        _Pragma("unroll") for (int k = 0; k < 32; ++k) { v[k] -= mu; qv += v[k] * v[k]; } \
        qv += bperm(qv, lane ^ 1); qv += bperm(qv, lane ^ 2); qv += bperm(qv, lane ^ 4); \
        const float rstd = __builtin_amdgcn_rsqf(qv * (1.f / 256.f) + GN_EPS); \
        if (gtok < n) { const int orow_ = rowbase + (cc_) * 64 + gtok;        \
            _Pragma("unroll") for (int u = 0; u < 4; ++u) { u32x4q o; \
                _Pragma("unroll") for (int e = 0; e < 4; ++e) o[e] = pkq(v[8 * u + 2 * e] * rstd * __uint_as_float(rg[u][e] << 16), v[8 * u + 2 * e + 1] * rstd * __uint_as_float(rg[u][e] & 0xffff0000u)); \
                *(u32x4q*)(RO + pg8::pk_elem(orow_, h * 256 + gseg * 32 + 8 * u, 32)) = o; } } } while (0)
#define RET_GATE(cc_) do { if (gtok < n) { const size_t gb = ((size_t)rowbase + (size_t)(cc_) * 64 + gtok) * 2048 + h * 256 + gseg * 32; \
        _Pragma("unroll") for (int u = 0; u < 4; ++u) rg[u] = *(const u32x4q*)(RG + gb + 8 * u); } } while (0)
    RET_GLOAD(0);
    u32x4q rg[4] = {{0u, 0u, 0u, 0u}, {0u, 0u, 0u, 0u}, {0u, 0u, 0u, 0u}, {0u, 0u, 0u, 0u}};
    for (int c = 0; c < nch; ++c) {
#pragma unroll
        for (int u = 0; u < 2; ++u) { const int row = qrow0 + 32 * u;
            *(LAS u32x4q*)(lds + L_KD + row * KDS + qch * 16) = scale8(rk[u], (row < n) ? __builtin_amdgcn_exp2f(lg2 * (float)(n - row)) : 0.f);
            if (WITH_OUT) { *(LAS u32x4q*)(lds + L_K + row * KS + qch * 16) = rk[u]; *(LAS u32x4q*)(lds + L_QD + row * KS + qch * 16) = scale8(rq[u], __builtin_amdgcn_exp2f(lg2 * (float)row)); } }
#pragma unroll
        for (int u = 0; u < 4; ++u) *(LAS u32x4q*)(lds + L_V + (vrow0 + 16 * u) * VS + vch * 16) = rv[u];
        if (c + 1 < nch) RET_GLOAD(c + 1);
        __syncthreads();
        if (WITH_OUT && c > 0) RET_GN(c - 1);
        if (WITH_OUT) RET_GATE(c);
        f32x16 O[2] = {{}, {}};
        if (WITH_OUT) {
            if (w < 4) {
                f32x16 X = {};
#pragma unroll
                for (int s = 0; s < 8; ++s) { const bf16x8 a = *(const LAS bf16x8*)(lds + L_K + (32 * xjb + r32) * KS + (16 * s + 8 * hi) * 2), bq = *(const LAS bf16x8*)(lds + L_QD + (32 * xib + r32) * KS + (16 * s + 8 * hi) * 2);
                    X = __builtin_amdgcn_mfma_f32_32x32x16_bf16(a, bq, X, 0, 0, 0); }
#pragma unroll
                for (int r = 0; r < 16; ++r) { const int j = 32 * xjb + crow(r, hi), i = 32 * xib + r32; X[r] *= __builtin_amdgcn_exp2f(lg2 * (float)(i >= j ? -j : j - 2 * i)); }
                *(LAS bf16x8*)(lds + L_XF + (w * 2 + 0) * 1024 + lane * 16) = pack8(X, 0);
                *(LAS bf16x8*)(lds + L_XF + (w * 2 + 1) * 1024 + lane * 16) = pack8(X, 8);
            }
#pragma unroll
            for (int d = 0; d < 4; ++d)
#pragma unroll
                for (int sp = 0; sp < 2; ++sp) { const bf16x8 sfr = pack8(S[d], 8 * sp);
#pragma unroll
                    for (int ib = 0; ib < 2; ++ib) { const LAS unsigned char* qp = lds + L_QD + (32 * ib + r32) * KS + (32 * d + 16 * sp + 4 * hi) * 2;
                        const s16x4 a0 = *(const LAS s16x4*)qp, a1 = *(const LAS s16x4*)(qp + 16);
                        O[ib] = __builtin_amdgcn_mfma_f32_32x32x16_bf16(cat(a0, a1), sfr, O[ib], 0, 0, 0); } }
        }
        bf16x8 vf[4];
#pragma unroll
        for (int q = 0; q < 4; ++q) { const LAS unsigned char* vp = lds + L_V + (16 * q + 4 * hi + (li >> 2)) * VS + (32 * w + 16 * grp + 4 * (li & 3)) * 2; vf[q] = cat(trd(vp), trd(vp + 8 * VS)); }
#pragma unroll
        for (int d = 0; d < 4; ++d) {
#pragma unroll
            for (int r = 0; r < 16; ++r) S[d][r] *= sdec;
#pragma unroll
            for (int q = 0; q < 4; ++q) { const LAS unsigned char* kp = lds + L_KD + (16 * q + 4 * hi + (li >> 2)) * KDS + (32 * d + 16 * grp + 4 * (li & 3)) * 2;
                S[d] = __builtin_amdgcn_mfma_f32_32x32x16_bf16(cat(trd(kp), trd(kp + 8 * KDS)), vf[q], S[d], 0, 0, 0); }
        }
        __syncthreads();
        if (WITH_OUT) {
#pragma unroll
            for (int q = 0; q < 4; ++q)
#pragma unroll
                for (int ib = 0; ib < 2; ++ib) { const bf16x8 pa = *(const LAS bf16x8*)(lds + L_XF + (((q >> 1) * 2 + ib) * 2 + (q & 1)) * 1024 + lane * 16);
                    O[ib] = __builtin_amdgcn_mfma_f32_32x32x16_bf16(pa, vf[q], O[ib], 0, 0, 0); }
#pragma unroll
            for (int ib = 0; ib < 2; ++ib)
#pragma unroll
                for (int r = 0; r < 16; ++r) *(LAS unsigned short*)(lds + L_OS + (32 * ib + crow(r, hi)) * OSS + (32 * w + r32) * 2) = (unsigned short)(pkq(O[ib][r], 0.f) & 0xffffu);
        }
    }
    if (WITH_OUT) {
        __syncthreads();
        RET_GN(nch - 1);
    }
    if (Sout) {
#pragma unroll
        for (int d = 0; d < 4; ++d)
#pragma unroll
            for (int r = 0; r < 16; ++r) Sout[(size_t)(32 * d + crow(r, hi)) * 256 + 32 * w + r32] = S[d][r];
    }
    __syncthreads();
#undef RET_GLOAD
#undef RET_GN
#undef RET_GATE
}
}
__device__ __forceinline__ float ret_lg2(int h) { return log1pf(-__builtin_amdgcn_exp2f((float)(-5 - h))) * LOG2E; }
__device__ __forceinline__ void ret_scan_phase(float* U, float* outP  , int gtid, int nthreads) {
    for (int e = gtid; e < 16 * 32768; e += nthreads) {
        const int bh = e >> 15, x = e & 32767, h = bh & 7;
        const float dec = __builtin_amdgcn_exp2f(ret_lg2(h) * (float)(ret::GCH * 64));
        float* p = U + (size_t)bh * 16 * 32768 + x;
        float u[16];
#pragma unroll
        for (int sc = 0; sc < 16; ++sc) u[sc] = p[(size_t)sc * 32768];
        float s = 0.f;
#pragma unroll
        for (int sc = 0; sc < 16; ++sc) { p[(size_t)sc * 32768] = s; s = s * dec + u[sc]; }
        outP[e] = s;
    }
}
#ifndef REP_ATTN
#define REP_ATTN 1
#endif
#ifndef REP_RET
#define REP_RET 1
#endif
#ifndef REP_FFNIN
#define REP_FFNIN 1
#endif
#ifndef REP_P0
#define REP_P0 1
#endif
#ifndef REP_FFNOUT
#define REP_FFNOUT 1
#endif
#ifndef REP_NORM
#define REP_NORM 1
#endif
#ifndef REP_FOXPROJ
#define REP_FOXPROJ 1
#endif
#ifndef REP_RETPROJ
#define REP_RETPROJ 1
#endif
struct Args { Ptrs P; int ph_lo, ph_hi, li, pad; };
constexpr int N_PHASES = 1 + 8 * 2 + 2 * 4 + 2 * 5 + 1 + 2 * 3 * (REP_RET - 1);
#ifndef PHMASK
#define PHMASK 0xffffffffu
#endif
#define EN(k) ((PHMASK >> (k)) & 1u)
#ifndef STAGGER
#define STAGGER 0
#endif
#define STAGGER_WAIT() do { if (STAGGER && (bxl & 1)) { _Pragma("unroll") for (int q_ = 0; q_ < STAGGER; ++q_) __builtin_amdgcn_s_sleep(127); } } while (0)
#ifndef FOX_PRUNE
#define FOX_PRUNE 0
#endif

__global__ void __launch_bounds__(NWAVES * 64, 2) mega_fwd(Args args) {
    extern __shared__ __attribute__((aligned(16))) unsigned char lds_raw[];
    LAS unsigned char* lds = (LAS unsigned char*)lds_raw;
    typedef const __attribute__((address_space(4))) Args* KArgs;
    const KArgs kap = (KArgs)__builtin_amdgcn_kernarg_segment_ptr();
    const int G = gridDim.x, bx = blockIdx.x;
    const int vcu = (G % 8 == 0) ? (bx % 8) * (G / 8) + bx / 8 : bx;
    const int NGW = G * NWAVES;
    unsigned char* ws = kap->P.ws;
    gu32* ctl = (gu32*)(ws + WS_CTL);
    for (int u = threadIdx.x; u < (LDS_BYTES - LDSCTL_OFF) / 4; u += NWAVES * 64) ((LAS unsigned*)(lds + LDSCTL_OFF))[u] = 0u;
    __syncthreads();
    volatile LAS unsigned* MISC = (volatile LAS unsigned*)(lds + MISC_OFF);
    XcdBarrier bar = xcd_barrier_post((unsigned*)(ctl + CW_BAR) + kap->li * XCD_BAR_WORDS, MISC + 8);
    const int lo = kap->ph_lo, hi = kap->ph_hi;
    int pid = 0;
#define PHASE_BEGIN if (pid >= lo && pid < hi) { KArgs kp_ = kap; asm volatile("" : "+s"(kp_)); \
        const Ptrs P = {kp_->P.x_prompt, kp_->P.x_sample, kp_->P.cache_k, kp_->P.cache_v, kp_->P.cache_lf, kp_->P.state_ret, kp_->P.norm_gains, kp_->P.w_ffn_in, kp_->P.w_ffn_out, kp_->P.fox_w_in, kp_->P.fox_b_f, \
                        kp_->P.fox_qg, kp_->P.fox_kg, kp_->P.fox_w_out, kp_->P.ret_w_in, kp_->P.ret_w_out, kp_->P.final_gain, kp_->P.out, kp_->P.ws}; (void)P; \
        unsigned char* ws = P.ws; gu32* ctl = (gu32*)(ws + WS_CTL); bf16* X = (bf16*)(ws + WS_X); float* SSQP = (float*)(ws + WS_SSQP); float* SSQS = (float*)(ws + WS_SSQS); (void)ctl; (void)X; (void)SSQP; (void)SSQS; \
        int tid = threadIdx.x; asm volatile("" : "+v"(tid)); const int lane = tid & 63, wave = __builtin_amdgcn_readfirstlane(tid >> 6), gw = vcu * NWAVES + wave; (void)lane; (void)gw; int bxl = blockIdx.x; asm volatile("" : "+s"(bxl)); (void)bxl;
#define PHASE_END   if (pid + 1 < hi) xcd_barrier(bar); } ++pid;

    bf16* X = (bf16*)(ws + WS_X); bf16* XN = (bf16*)(ws + WS_XN);
    float* SSQP = (float*)(ws + WS_SSQP); float* SSQS = (float*)(ws + WS_SSQS);
    LAS float* rsb = (LAS float*)(lds + RSB_OFF);

#define SAMPLE_WIDE(EpiT, nb_, woff_, ...) do { unsigned char* ws2 = P.ws; asm volatile("" : "+s"(ws2));     \
        LAS float* rsl_ = (LAS float*)(lds + RSB_OFF) + 13 * 256; const EpiT E2_ = __VA_ARGS__; \
        const bool g256_ = (G == 256); const int t_ = (bxl & 7) * (nb_) + (bxl >> 3); \
        int L_ = g256_ ? (((bxl >> 3) < (nb_)) ? (t_ & 7) + 8 * (t_ >> 3) : 8 * (nb_)) : vcu; const int st_ = g256_ ? 8 * (nb_) : G; \
        for (; L_ < 8 * (nb_); L_ += st_) pg8::sample_wide_unit<EpiT>(lds + RING_OFF, rsl_, (const bf16*)(ws2 + WS_X), (const bf16*)(ws2 + (woff_)), (const float*)(ws2 + WS_SSQS), L_, E2_); } while (0)

    PHASE_BEGIN if (EN(0)) for (int rep = 0; rep < REP_P0; ++rep) { p0_prologue(P, lds, gw, NGW, wave, lane); if (rep + 1 < REP_P0) xcd_barrier(bar); } PHASE_END

    for (int s = 0; s < 8; ++s) {
        const int layer = s >> 1, half = s & 1, jl = layer >> 1;
        PHASE_BEGIN if (EN(2)) for (int rep = 0; rep < REP_FFNIN; ++rep) {
            if (rep) xcd_barrier(bar);
            pg8::Gemm g{X, (const bf16*)(ws + WS_WFI + (size_t)s * WFI_STRIDE), MP, 2 * FF, DM}; pg8::StaticOrder S; S.init(MP, 2 * FF, G, bxl);
            const pg8::RstdHook<pg8::StaticOrder> RH{S, SSQP, SSQS, rsb};
            pg8::EpiSwiglu E{(bf16*)(ws + WS_ACT), FF, rsb};
            pg8::gemm_phase<pg8::EpiSwiglu, pg8::StaticOrder, true, true, DM, true, true, pg8::RstdHook<pg8::StaticOrder>>(lds + RING_OFF, g, S, E, RH);
            SAMPLE_WIDE(pg8::EpiSwiglu, 22, WS_WFI + (size_t)s * WFI_STRIDE, {(bf16*)(ws2 + WS_ACT), FF, nullptr});
        } PHASE_END
        PHASE_BEGIN if (EN(3)) {
            const bf16* wfo = (const bf16*)(ws + WS_WFO + (size_t)s * WFO_STRIDE);
            pg8::Gemm g{(const bf16*)(ws + WS_ACT), wfo, MP, DM, FF}; pg8::StaticOrder S; S.init(MP, DM, G, bxl);
            pg8::EpiResid E{X, 0.5f, SSQP};
            pg8::gemm_phase<pg8::EpiResid, pg8::StaticOrder, true, true, FF, true, true>(lds + RING_OFF, g, S, E);
            for (int L = vcu; L < 256; L += G) small_gemm_resid<true, true>((const bf16*)(ws + WS_ACT), wfo, FF, X, 0.5f, L, lds, SSQS);
        } PHASE_END
        if (half == 0) {
            if ((layer & 1) == 0) {
#define LOGF ((float*)(ws + WS_LOGF))
#define ND ((float*)(ws + WS_ND))
#define Qb ((bf16*)(ws + WS_Q))
#define Kb ((bf16*)(ws + WS_K))
#define Vb ((bf16*)(ws + WS_V))
#define OGb ((bf16*)(ws + WS_OG))
#define AOb ((bf16*)(ws + WS_AO))
                PHASE_BEGIN if (EN(4)) forget_phase(X, P.norm_gains + (size_t)layer * 3 * DM + DM, (const float*)(ws + WS_WF) + (size_t)jl * 16 * 1024, P.fox_b_f + jl * 16, LOGF,
                                             P.out + O_FLP + (size_t)jl * MP * 16, P.out + O_FLS + (size_t)jl * MS * 16, lds, gw, NGW, tid, lane); PHASE_END
                PHASE_BEGIN if (EN(5)) for (int rep = 0; rep < REP_FOXPROJ; ++rep) {
                    if (rep) xcd_barrier(bar);
                    if (bxl >= G - 32) {
                        const float mq = wave_max(fabsf(P.fox_qg[jl * 64 + lane]), lane), mk = wave_max(fabsf(P.fox_kg[jl * 64 + lane]), lane);
                        cumsum_unit(LOGF, ND, bxl - (G - 32), lds, tid, wave, lane, FOX_PRUNE_T + 2.f * (8.f * mq * mk * LOG2E), (int*)(ws + WS_T0)); }
                    if (tid < 128) ((LAS float*)(lds + GL_OFF))[tid] = (tid < 64) ? P.fox_qg[jl * 64 + tid] : P.fox_kg[jl * 64 + tid - 64];
                    __syncthreads();
                    pg8::Gemm g{X, (const bf16*)(ws + WS_WXI + (size_t)jl * WXI_STRIDE), MP, 4096, DM}; pg8::StaticOrder S; S.init(MP, 4096, G, bxl);
                    const pg8::RstdHook<pg8::StaticOrder> RH{S, SSQP, SSQS, rsb};
                    pg8::EpiFoxProj E{Qb, Kb, Vb, OGb, nullptr, nullptr, nullptr, nullptr,
                                      (const LAS float*)(lds + GL_OFF), rsb, attn_body::C2};
                    pg8::gemm_phase<pg8::EpiFoxProj, pg8::StaticOrder, true, true, DM, true, true, pg8::RstdHook<pg8::StaticOrder>>(lds + RING_OFF, g, S, E, RH);
                    SAMPLE_WIDE(pg8::EpiFoxProj, 16, WS_WXI + (size_t)jl * WXI_STRIDE, {(bf16*)(ws2 + WS_Q), (bf16*)(ws2 + WS_K), (bf16*)(ws2 + WS_V), (bf16*)(ws2 + WS_OG), nullptr, nullptr, nullptr, nullptr, (const LAS float*)(lds + GL_OFF), nullptr, attn_body::C2});
                } PHASE_END
                PHASE_BEGIN if (EN(6)) {
                    for (int rep = 0; rep < REP_ATTN; ++rep) {
                    if (rep) xcd_barrier(bar);
                    gu32* tkt = ctl + 1024 + 64 * jl + 128 * rep;
                    ((LAS v4u*)(lds + RSB_OFF))[tid] = ((const v4u*)(ws + WS_T0))[tid]; __syncthreads();
                    for (;;) {
                        int tq_ = threadIdx.x; asm volatile("" : "+v"(tq_));
                        if (tq_ == 0) MISC[16] = __hip_atomic_fetch_add(tkt, 1u, __ATOMIC_RELAXED, __HIP_MEMORY_SCOPE_AGENT);
                        __syncthreads();
                        const int k = (int)MISC[16];
                        __syncthreads();
                        if (k >= 2560) break;
                        const int kq = (k < 2048) ? (k >> 3) : 0, kr = (k < 2048) ? (k & 7) + 2 : 0;
                        if (kr == 8) { if (EN(7)) smp::unit(jl, kq >> 4, kq & 15, P.cache_k, P.cache_v, P.cache_lf, LOGF, Qb, Kb, Vb, OGb, AOb, lds + RING_OFF); continue; }
                        if (kr == 9) { kv_out_chunk(Kb, Vb, P.out + O_FKP + (size_t)jl * MP * DM, P.out + O_FVP + (size_t)jl * MP * DM, P.out + O_FKS + (size_t)jl * MS * DM, P.out + O_FVS + (size_t)jl * MS * DM, kq); continue; }
                        const int u = (k < 2048) ? kq * 6 + (kr - 2) : k - 512, bh = u & 31, qb = 63 - (u >> 5);
                        const int t0 = FOX_PRUNE ? __builtin_amdgcn_readfirstlane(((const LAS int*)(lds + RSB_OFF))[bh * 64 + qb]) : 0;
                        attn_body::attn_unit<8>(bh >> 4, bh & 15, qb, t0, (const attn_body::bf16*)Qb, (const attn_body::bf16*)Kb, (const attn_body::bf16*)Vb, (const attn_body::bf16*)OGb, ND,
                                                (attn_body::bf16*)AOb, (char*)lds_raw + RING_OFF);
                    }
                    }
                } PHASE_END
                PHASE_BEGIN if (EN(8)) {
                    const bf16* wxo = (const bf16*)(ws + WS_WXO + (size_t)jl * WXO_STRIDE);
                    pg8::Gemm g{AOb, wxo, MP, DM, DM}; pg8::StaticOrder S; S.init(MP, DM, G, bxl);
                    pg8::EpiResid E{X, 1.0f, SSQP};
                    pg8::gemm_phase<pg8::EpiResid, pg8::StaticOrder, true, true, DM, false, true>(lds + RING_OFF, g, S, E);
                    for (int L = vcu; L < 256; L += G) small_gemm_resid<false, true>(AOb, wxo, DM, X, 1.0f, L, lds, SSQS);
                } PHASE_END
            } else {
#define RQ ((bf16*)(ws + WS_RQ))
#define RK ((bf16*)(ws + WS_RK))
#define RV ((bf16*)(ws + WS_RV))
#define RG ((bf16*)(ws + WS_RG))
#define RO ((bf16*)(ws + WS_RO))
#define U ((float*)(ws + WS_U))
                PHASE_BEGIN if (EN(10)) for (int rep = 0; rep < REP_RETPROJ; ++rep) {
                    if (rep) xcd_barrier(bar);
                    pg8::Gemm g{X, (const bf16*)(ws + WS_WRI + (size_t)jl * WRI_STRIDE), MP, 6144, DM}; pg8::StaticOrder S; S.init(MP, 6144, G, bxl);
                    const pg8::RstdHook<pg8::StaticOrder> RH{S, SSQP, SSQS, rsb};
                    pg8::EpiRetProj E{RQ, RK, RV, RG, rsb};
                    pg8::gemm_phase<pg8::EpiRetProj, pg8::StaticOrder, true, true, DM, true, true, pg8::RstdHook<pg8::StaticOrder>>(lds + RING_OFF, g, S, E, RH);
                    SAMPLE_WIDE(pg8::EpiRetProj, 24, WS_WRI + (size_t)jl * WRI_STRIDE, {(bf16*)(ws2 + WS_RQ), (bf16*)(ws2 + WS_RK), (bf16*)(ws2 + WS_RV), (bf16*)(ws2 + WS_RG), nullptr});
                } PHASE_END
                for (int rrep = 0; rrep < REP_RET; ++rrep) {
                PHASE_BEGIN if (EN(11)) {
                    for (int L = vcu; L < 256; L += G) { const int bh = L >> 4, sc = L & 15, b = bh >> 3, h = bh & 7;
                        ret::unit<false>(lds + RING_OFF, b * SEQ + sc * (ret::GCH * 64), ret::GCH, 64, h, ret_lg2(h), RQ, RK, RV, RG, RO, nullptr, U + (size_t)(bh * 16 + sc) * 32768); }
                } PHASE_END
                PHASE_BEGIN if (EN(12)) ret_scan_phase(U, P.out + O_RP + (size_t)jl * 16 * 32768, gw * 64 + lane, NGW * 64); PHASE_END
                PHASE_BEGIN if (EN(13)) {
                    for (int L = vcu; L < 256; L += G) { const int bh = L >> 4, sc = L & 15, b = bh >> 3, h = bh & 7;
                        ret::unit<true>(lds + RING_OFF, b * SEQ + sc * (ret::GCH * 64), ret::GCH, 64, h, ret_lg2(h), RQ, RK, RV, RG, RO, U + (size_t)(bh * 16 + sc) * 32768, nullptr); }
                    for (int L = vcu; L < 128; L += G) { const int b = L >> 3, h = L & 7;
                        ret::unit<true>(lds + RING_OFF, MP + b * DEC_S, 1, DEC_S, h, ret_lg2(h), RQ, RK, RV, RG, RO, P.state_ret + ((size_t)(jl * DEC_B + b) * 8 + h) * 32768,
                                        P.out + O_RS + ((size_t)(jl * DEC_B + b) * 8 + h) * 32768); }
                } PHASE_END
                }
                PHASE_BEGIN if (EN(15)) {
                    const bf16* wro = (const bf16*)(ws + WS_WRO + (size_t)jl * WRO_STRIDE);
                    pg8::Gemm g{RO, wro, MP, DM, 2048}; pg8::StaticOrder S; S.init(MP, DM, G, bxl);
                    pg8::EpiResid E{X, 1.0f, SSQP};
                    pg8::gemm_phase<pg8::EpiResid, pg8::StaticOrder, true, true, 2048, true, true>(lds + RING_OFF, g, S, E);
                    for (int L = vcu; L < 256; L += G) small_gemm_resid<true, true>(RO, wro, 2048, X, 1.0f, L, lds, SSQS);
                } PHASE_END
            }
        }
    }
    PHASE_BEGIN if (EN(16)) final_norm_phase(X, P.final_gain, P.out + O_YP, P.out + O_YS, gw, NGW, lane); PHASE_END
#undef PHASE_BEGIN
#undef PHASE_END
}

#ifndef MK_N_LAUNCHES
#define MK_N_LAUNCHES 1
#endif
#undef LOGF
#undef ND
#undef Qb
#undef Kb
#undef Vb
#undef OGb
#undef AOb
#undef RQ
#undef RK
#undef RV
#undef RG
#undef RO
#undef U
extern "C" void kernel_launch(void* const* d_in, const int* in_sizes, int n_in, void* d_out, int out_size, void* d_ws, size_t ws_size, hipStream_t stream) {
    static int grid = 0;
    if (grid == 0) {
        if (n_in != 17 || (size_t)out_size != O_END || ws_size < WS_END) { fprintf(stderr, "kernel_launch: built for 17 inputs, %zu outputs, >= %zu bytes of workspace; got n_in %d, out %d, ws %zu; nothing launched\n", (size_t)O_END, (size_t)WS_END, n_in, out_size, ws_size); grid = -1; return; }
        int dev = 0, cus = 0, per_cu = 0;
        if (hipGetDevice(&dev) != hipSuccess || hipDeviceGetAttribute(&cus, hipDeviceAttributeMultiprocessorCount, dev) != hipSuccess) { fprintf(stderr, "kernel_launch: device query failed\n"); grid = -1; return; }
        if (hipFuncSetAttribute((const void*)mega_fwd, hipFuncAttributeMaxDynamicSharedMemorySize, LDS_BYTES) != hipSuccess) { fprintf(stderr, "kernel_launch: hipFuncSetAttribute failed\n"); grid = -1; return; }
        if (hipOccupancyMaxActiveBlocksPerMultiprocessor(&per_cu, (const void*)mega_fwd, NWAVES * 64, LDS_BYTES) != hipSuccess || per_cu < 1)
            fprintf(stderr, "kernel_launch: note: occupancy query reports %d workgroups per CU\n", per_cu);
        (void)hipGetLastError();
        grid = cus;
    }
    if (grid < 0) return;
    if (hipMemsetAsync((char*)d_ws + WS_CTL, 0, CTL_ZERO_BYTES, stream) != hipSuccess) { fprintf(stderr, "kernel_launch: memset failed\n"); return; }
    Args a{};
    const float** pp = (const float**)&a.P;
    for (int i = 0; i < 17; ++i) pp[i] = (const float*)d_in[i];
    a.P.out = (float*)d_out; a.P.ws = (unsigned char*)d_ws;
    const int NL = MK_N_LAUNCHES;
    for (int li = 0; li < NL; ++li) {
        a.ph_lo = (int)((long)N_PHASES * li / NL); a.ph_hi = (int)((long)N_PHASES * (li + 1) / NL); a.li = li; a.pad = 0;
        hipLaunchKernelGGL(mega_fwd, dim3(grid), dim3(NWAVES * 64), LDS_BYTES, stream, a);
        const hipError_t le = hipPeekAtLastError();
        if (le != hipSuccess) { fprintf(stderr, "kernel_launch: launch %d failed: %s\n", li, hipGetErrorName(le)); break; }
    }
}
```
